# Optimizing an MI355X kernel written in HIP

```python
import jax, jax.numpy as jnp
from jax import lax
import numpy as np

D_MODEL = 1024
BATCH = 2
SEQ = 8192
DEPTH = 2
DEC_BATCH = 128
DEC_SEQ = 8
PAST_LEN = 8192
PAGE_SIZE = 128

N_HEADS = 16
QK_NOPE = 64
QK_ROPE = 32
V_HEAD = 64
Q_LORA = 512
KV_LORA = 256
ROPE_THETA = 10000.0
ATTN_SCALE = (QK_NOPE + QK_ROPE) ** -0.5
Q_BLOCK = 128
POOL_WINDOWS = (2, 4, 8, 16)
N_GROUPS = 4
GROUP_W = D_MODEL // N_GROUPS
POOL_BUF = 16 - 1
D_FF = 2816
CONV_W = 3
CONV_BUF = CONV_W - 1
N_MIXERS = 2
N_MLA_LAYERS = (DEPTH + 1) // 2
N_POOL_LAYERS = DEPTH // 2
EPS = 1e-6

kernel_name = 'hybrid_mla_pool_convffn_step'


def rms_norm(x, g):
    xf = x.astype(jnp.float32)
    y = xf * lax.rsqrt(jnp.mean(xf * xf, axis=-1, keepdims=True) + EPS)
    return (y * g.astype(jnp.float32)).astype(x.dtype)


def modulate(x, g, shift, scale):
    return rms_norm(x, g) * (1 + scale[:, None, :]) + shift[:, None, :]


def adaln(c, w, b):
    m = jax.nn.silu(c) @ w + b
    return jnp.split(m, 6, axis=-1)


def rope(x, pos):
    half = QK_ROPE // 2
    inv = ROPE_THETA ** (-jnp.arange(half, dtype=jnp.float32) / half)
    ang = pos.astype(jnp.float32)[:, None] * inv[None, :]
    shape = (1, ang.shape[0]) + (1,) * (x.ndim - 3) + (half,)
    cos = jnp.cos(ang).reshape(shape)
    sin = jnp.sin(ang).reshape(shape)
    x1 = x[..., :half].astype(jnp.float32)
    x2 = x[..., half:].astype(jnp.float32)
    out = jnp.concatenate([x1 * cos - x2 * sin, x2 * cos + x1 * sin], axis=-1)
    return out.astype(x.dtype)


def mla_project(h, pos, w_dq, q_norm, w_uq, w_dkv, kv_norm, w_uk):
    B, T, _ = h.shape
    cq = rms_norm(h @ w_dq, q_norm)
    q = (cq @ w_uq).reshape(B, T, N_HEADS, QK_NOPE + QK_ROPE)
    q_rope = rope(q[..., QK_NOPE:], pos)
    q_lat = jnp.einsum('bthn,khn->bthk', q[..., :QK_NOPE], w_uk)
    kv = h @ w_dkv
    ckv = rms_norm(kv[..., :KV_LORA], kv_norm)
    kr = rope(kv[..., KV_LORA:], pos)
    return q_lat, q_rope, ckv, kr


def mla_prompt_attend(q_lat, q_rope, ckv, kr):
    B, T = q_lat.shape[0], q_lat.shape[1]
    key_pos = jnp.arange(T)

    def block(i):
        s0 = i * Q_BLOCK
        qb = lax.dynamic_slice_in_dim(q_lat, s0, Q_BLOCK, axis=1)
        qrb = lax.dynamic_slice_in_dim(q_rope, s0, Q_BLOCK, axis=1)
        s = (jnp.einsum('bqhk,bsk->bhqs', qb, ckv)
             + jnp.einsum('bqhr,bsr->bhqs', qrb, kr)).astype(jnp.float32) * ATTN_SCALE
        qpos = s0 + jnp.arange(Q_BLOCK)
        s = jnp.where(key_pos[None, :] <= qpos[:, None], s, -jnp.inf)
        p = jax.nn.softmax(s, axis=-1).astype(ckv.dtype)
        return jnp.einsum('bhqs,bsk->bqhk', p, ckv)

    o = lax.map(block, jnp.arange(T // Q_BLOCK))
    return o.transpose(1, 0, 2, 3, 4).reshape(B, T, N_HEADS, KV_LORA)


def mla_sample_attend(q_lat, q_rope, ckv_new, kr_new, ckv_past, kr_past):
    S = q_lat.shape[1]
    P = ckv_past.shape[1]
    s_past = (jnp.einsum('bqhk,bsk->bhqs', q_lat, ckv_past)
              + jnp.einsum('bqhr,bsr->bhqs', q_rope, kr_past)).astype(jnp.float32) * ATTN_SCALE
    s_new = (jnp.einsum('bqhk,bsk->bhqs', q_lat, ckv_new)
             + jnp.einsum('bqhr,bsr->bhqs', q_rope, kr_new)).astype(jnp.float32) * ATTN_SCALE
    causal = jnp.tril(jnp.ones((S, S), dtype=bool))
    s_new = jnp.where(causal, s_new, -jnp.inf)
    p = jax.nn.softmax(jnp.concatenate([s_past, s_new], axis=-1), axis=-1).astype(ckv_new.dtype)
    return (jnp.einsum('bhqs,bsk->bqhk', p[..., :P], ckv_past)
            + jnp.einsum('bhqs,bsk->bqhk', p[..., P:], ckv_new))


def mla_out(o_lat, w_uv, w_o):
    B, T = o_lat.shape[0], o_lat.shape[1]
    o = jnp.einsum('bthk,khv->bthv', o_lat, w_uv).reshape(B, T, N_HEADS * V_HEAD)
    return o @ w_o


def pool_mix(h, prev, pos0, w_grp, ls):
    B, T, D = h.shape
    xp = jnp.concatenate([prev.astype(h.dtype), h], axis=1)
    xf = xp.astype(jnp.float32)
    cs = jnp.concatenate([jnp.zeros((B, 1, D), jnp.float32), jnp.cumsum(xf, axis=1)], axis=1)
    pos = pos0 + jnp.arange(T)
    outs = []
    for g, w in enumerate(POOL_WINDOWS):
        sl = slice(g * GROUP_W, (g + 1) * GROUP_W)
        win_sum = cs[:, POOL_BUF + 1:, sl] - cs[:, POOL_BUF + 1 - w:POOL_BUF + 1 - w + T, sl]
        cnt = jnp.minimum(pos + 1, w).astype(jnp.float32)[None, :, None]
        pooled = (win_sum / cnt - xf[:, POOL_BUF:, sl]).astype(h.dtype)
        outs.append(jnp.einsum('btc,cd->btd', pooled, w_grp[g]))
    return jnp.concatenate(outs, axis=-1) * ls, xp[:, -POOL_BUF:]


def conv_ffn(h, prev, w_up, conv_w, conv_b, w_down):
    T = h.shape[1]
    u = h @ w_up
    up = jnp.concatenate([prev.astype(u.dtype), u], axis=1)
    conv = conv_b + up[:, 0:T] * conv_w[0]
    for k in range(1, CONV_W):
        conv = conv + up[:, k:k + T] * conv_w[k]
    y = (jax.nn.silu(conv[..., :D_FF]) * conv[..., D_FF:]) @ w_down
    return y, up[:, -CONV_BUF:]


def setup_inputs(seed: int = 0) -> dict:
    key = jax.random.key(seed)
    ks = jax.random.split(key, 40)
    f32 = jnp.float32
    n_pages = PAST_LEN // PAGE_SIZE
    used_pages = DEC_BATCH * n_pages
    n_pool_pages = used_pages + used_pages // 4
    nrm = lambda k, shape, s: jax.random.normal(k, shape, f32) * s
    page_table = jax.random.permutation(ks[0], n_pool_pages)[:used_pages].reshape(DEC_BATCH, n_pages).astype(jnp.int32)
    return {
        'x_prompt': nrm(ks[1], (BATCH, SEQ, D_MODEL), 1.0),
        'x_sample': nrm(ks[2], (DEC_BATCH, DEC_SEQ, D_MODEL), 1.0),
        'cache_kv_latent': nrm(ks[3], (N_MLA_LAYERS, n_pool_pages, PAGE_SIZE, KV_LORA), 1.0),
        'cache_k_rope': nrm(ks[4], (N_MLA_LAYERS, n_pool_pages, PAGE_SIZE, QK_ROPE), 1.0),
        'state_pool': nrm(ks[5], (N_POOL_LAYERS, DEC_BATCH, POOL_BUF, D_MODEL), 1.0),
        'state_conv': nrm(ks[6], (DEPTH, DEC_BATCH, CONV_BUF, 2 * D_FF), 1.0),
        'page_table': page_table,
        'c_prompt': nrm(ks[7], (BATCH, D_MODEL), 1.0),
        'c_sample': nrm(ks[8], (DEC_BATCH, D_MODEL), 1.0),
        'ada_w': nrm(ks[9], (DEPTH, D_MODEL, 6 * D_MODEL), 0.5 * D_MODEL ** -0.5),
        'ada_b': nrm(ks[10], (DEPTH, 6 * D_MODEL), 0.02),
        'norm_mix_pre': 1.0 + nrm(ks[11], (DEPTH, D_MODEL), 0.1),
        'norm_mix_post': 1.0 + nrm(ks[12], (DEPTH, D_MODEL), 0.1),
        'norm_ffn_pre': 1.0 + nrm(ks[13], (DEPTH, D_MODEL), 0.1),
        'norm_ffn_post': 1.0 + nrm(ks[14], (DEPTH, D_MODEL), 0.1),
        'mla_w_dq': nrm(ks[15], (N_MLA_LAYERS, D_MODEL, Q_LORA), D_MODEL ** -0.5),
        'mla_q_norm': 1.0 + nrm(ks[16], (N_MLA_LAYERS, Q_LORA), 0.1),
        'mla_w_uq': nrm(ks[17], (N_MLA_LAYERS, Q_LORA, N_HEADS * (QK_NOPE + QK_ROPE)), Q_LORA ** -0.5),
        'mla_w_dkv': nrm(ks[18], (N_MLA_LAYERS, D_MODEL, KV_LORA + QK_ROPE), D_MODEL ** -0.5),
        'mla_kv_norm': 1.0 + nrm(ks[19], (N_MLA_LAYERS, KV_LORA), 0.1),
        'mla_w_uk': nrm(ks[20], (N_MLA_LAYERS, KV_LORA, N_HEADS, QK_NOPE), KV_LORA ** -0.5),
        'mla_w_uv': nrm(ks[21], (N_MLA_LAYERS, KV_LORA, N_HEADS, V_HEAD), KV_LORA ** -0.5),
        'mla_w_o': nrm(ks[22], (N_MLA_LAYERS, N_HEADS * V_HEAD, D_MODEL), (N_HEADS * V_HEAD) ** -0.5),
        'pool_w': nrm(ks[23], (N_POOL_LAYERS, N_GROUPS, GROUP_W, GROUP_W), GROUP_W ** -0.5),
        'pool_scale': 1.0 + nrm(ks[24], (N_POOL_LAYERS, D_MODEL), 0.1),
        'ffn_w_up': nrm(ks[25], (DEPTH, D_MODEL, 2 * D_FF), D_MODEL ** -0.5),
        'ffn_conv_w': nrm(ks[26], (DEPTH, CONV_W, 2 * D_FF), CONV_W ** -0.5),
        'ffn_conv_b': nrm(ks[27], (DEPTH, 2 * D_FF), 0.02),
        'ffn_w_down': nrm(ks[28], (DEPTH, D_FF, D_MODEL), D_FF ** -0.5),
    }


def reference(x_prompt, x_sample, cache_kv_latent, cache_k_rope, state_pool, state_conv, page_table,
              c_prompt, c_sample, ada_w, ada_b, norm_mix_pre, norm_mix_post, norm_ffn_pre, norm_ffn_post,
              mla_w_dq, mla_q_norm, mla_w_uq, mla_w_dkv, mla_kv_norm, mla_w_uk, mla_w_uv, mla_w_o,
              pool_w, pool_scale, ffn_w_up, ffn_conv_w, ffn_conv_b, ffn_w_down):
    B, T = x_prompt.shape[0], x_prompt.shape[1]
    Bd, S = x_sample.shape[0], x_sample.shape[1]
    n_pages = page_table.shape[1]
    past = n_pages * PAGE_SIZE
    pos_p = jnp.arange(T)
    pos_s = past + jnp.arange(S)
    pool_zero = jnp.zeros((B, POOL_BUF, D_MODEL), x_prompt.dtype)
    conv_zero = jnp.zeros((B, CONV_BUF, 2 * D_FF), x_prompt.dtype)

    xp, xs = x_prompt, x_sample
    kv_p, kr_p, kv_s, kr_s = [], [], [], []
    pool_p, pool_s, conv_p, conv_s = [], [], [], []
    for i in range(DEPTH):
        sh_mp, sc_mp, g_mp, sh_fp, sc_fp, g_fp = adaln(c_prompt, ada_w[i], ada_b[i])
        sh_ms, sc_ms, g_ms, sh_fs, sc_fs, g_fs = adaln(c_sample, ada_w[i], ada_b[i])
        hp = modulate(xp, norm_mix_pre[i], sh_mp, sc_mp)
        hs = modulate(xs, norm_mix_pre[i], sh_ms, sc_ms)
        j = i // N_MIXERS
        if i % N_MIXERS == 0:
            ql, qr, ckv, kr = mla_project(hp, pos_p, mla_w_dq[j], mla_q_norm[j], mla_w_uq[j],
                                          mla_w_dkv[j], mla_kv_norm[j], mla_w_uk[j])
            op = mla_out(mla_prompt_attend(ql, qr, ckv, kr), mla_w_uv[j], mla_w_o[j])
            qls, qrs, ckvs, krs = mla_project(hs, pos_s, mla_w_dq[j], mla_q_norm[j], mla_w_uq[j],
                                              mla_w_dkv[j], mla_kv_norm[j], mla_w_uk[j])
            ckv_past = cache_kv_latent[j, page_table].reshape(Bd, past, KV_LORA).astype(hs.dtype)
            kr_past = cache_k_rope[j, page_table].reshape(Bd, past, QK_ROPE).astype(hs.dtype)
            os_ = mla_out(mla_sample_attend(qls, qrs, ckvs, krs, ckv_past, kr_past), mla_w_uv[j], mla_w_o[j])
            kv_p.append(ckv); kr_p.append(kr); kv_s.append(ckvs); kr_s.append(krs)
        else:
            op, st_p = pool_mix(hp, pool_zero, 0, pool_w[j], pool_scale[j])
            os_, st_s = pool_mix(hs, state_pool[j], past, pool_w[j], pool_scale[j])
            pool_p.append(st_p); pool_s.append(st_s)
        xp = xp + g_mp[:, None, :] * rms_norm(op, norm_mix_post[i])
        xs = xs + g_ms[:, None, :] * rms_norm(os_, norm_mix_post[i])

        hp = modulate(xp, norm_ffn_pre[i], sh_fp, sc_fp)
        hs = modulate(xs, norm_ffn_pre[i], sh_fs, sc_fs)
        fp, cst_p = conv_ffn(hp, conv_zero, ffn_w_up[i], ffn_conv_w[i], ffn_conv_b[i], ffn_w_down[i])
        fs, cst_s = conv_ffn(hs, state_conv[i], ffn_w_up[i], ffn_conv_w[i], ffn_conv_b[i], ffn_w_down[i])
        xp = xp + g_fp[:, None, :] * rms_norm(fp, norm_ffn_post[i])
        xs = xs + g_fs[:, None, :] * rms_norm(fs, norm_ffn_post[i])
        conv_p.append(cst_p); conv_s.append(cst_s)

    new_kv_p = jnp.stack(kv_p)
    new_kr_p = jnp.stack(kr_p)
    new_kv_s = jnp.stack(kv_s)
    new_kr_s = jnp.stack(kr_s)
    new_pool_p = jnp.stack(pool_p)
    new_pool_s = jnp.stack(pool_s)
    new_conv_p = jnp.stack(conv_p)
    new_conv_s = jnp.stack(conv_s)
    return (xp, xs, new_kv_p, new_kr_p, new_kv_s, new_kr_s, new_pool_p, new_pool_s, new_conv_p, new_conv_s)
```

```cpp
#include <hip/hip_runtime.h>
#include <cstdio>
#include <cstdint>
#include <cmath>
#define ATT_ORDER 3
__device__ __forceinline__ int opaque_tid() { int t = threadIdx.x; asm volatile("" : "+v"(t)); return t; }
namespace pg8 {
#define PG8_LAS __attribute__((address_space(3)))
typedef unsigned short bf16_t;
typedef short bf16x8 __attribute__((ext_vector_type(8)));
typedef float f32x4 __attribute__((ext_vector_type(4)));
typedef unsigned u32x4 __attribute__((ext_vector_type(4)));
constexpr int BM = 256, BK = 64, HALF = 128, HTB = HALF * BK * 2  , STAGE_BYTES = 8 * HTB, NXCD = 8, WGM = 8;

__host__ __device__ __forceinline__ int lds_byte(int r, int c) { const int st = (r >> 4) * 2 + (c >> 5), rr = r & 15, cc = c & 31, ob = rr * 64 + cc * 2; return st * 1024 + (ob ^ (((ob >> 9) & 1) << 5)); }
__host__ __device__ __forceinline__ void stage_rc(int b, int& R, int& C) { const int st = b / 1024, sb = b % 1024, swz = sb ^ (((sb >> 9) & 1) << 5); R = (st >> 1) * 16 + swz / 64; C = (st & 1) * 32 + (swz % 64) / 2; }
__host__ __device__ __forceinline__ int perm32(int rho) { const int n = rho >> 4, i = rho & 15; return 8 * (i >> 2) + 4 * n + (i & 3); }

struct Unit { int pm, pn, pk, nt; };
struct Gemm { const bf16_t* A; const bf16_t* Bt; int M, N, K; int lda, agroup, ldb; };

struct StaticOrder {
    int nM, nN, nwg, G, c;
    __host__ __device__ void init(int M, int N, int G_, int c_) { nM = M / BM; nN = N / BM; nwg = nM * nN; G = G_; c = c_; }
    __host__ __device__ bool next(int i, Unit& u) const {
        const long L = (long)i * G + c; if (L >= nwg) return false;
        int wgid = (int)L; { const int q = nwg / NXCD, r = nwg % NXCD, xcd = wgid % NXCD, off = wgid / NXCD; wgid = (xcd < r ? xcd * (q + 1) : r * (q + 1) + (xcd - r) * q) + off; }
        const int nig = WGM * nN, gid = wgid / nig, fm = gid * WGM, gsz = (nM - fm) < WGM ? (nM - fm) : WGM;
        u.pm = fm + ((wgid % nig) % gsz); u.pn = (wgid % nig) / gsz; u.pk = 0; u.nt = 0; return true;
    }
    __device__ __forceinline__ void a_ready(const Unit&) const {}
    __device__ __forceinline__ void done(const Unit&) const {}
};

typedef float f32x2c __attribute__((ext_vector_type(2))); typedef __bf16 bf16x2c __attribute__((ext_vector_type(2)));
__device__ __forceinline__ unsigned cvt_pk_bf16(float lo, float hi) { const f32x2c v = {lo, hi}; const bf16x2c b = __builtin_convertvector(v, bf16x2c); return __builtin_bit_cast(unsigned, b); }
typedef float f32x2 __attribute__((ext_vector_type(2)));
__device__ __forceinline__ f32x2 gelu_pk(f32x2 v) {
    const f32x2 av = __builtin_elementwise_abs(v), d = av * 0.2316418882f + 1.0f;
    f32x2 t; t.x = __builtin_amdgcn_rcpf(d.x); t.y = __builtin_amdgcn_rcpf(d.y);
    f32x2 q = t * 0.5307027145f + (-0.7265760135f); q = q * t + 0.7107068705f; q = q * t + (-0.142248368f); q = q * t + 0.127414796f; q = q * t;
    const f32x2 s = (v * v) * (-0.72134752044f);
    f32x2 e; e.x = __builtin_amdgcn_exp2f(s.x); e.y = __builtin_amdgcn_exp2f(s.y);
    const f32x2 m = v * (q * e), r = v - m;
    f32x2 o; o.x = v.x < 0.f ? m.x : r.x; o.y = v.y < 0.f ? m.y : r.y; return o;
}

template <int ACT  > struct EpiBf16 {
    static constexpr bool PERM = true, AFTER_DRAIN = false; static_assert(ACT == 0 || ACT == 1, "EpiBf16: ACT is 0 (none) or 1 (gelu_pk)");
    bf16_t* O; int ldc; const float* bias; int split_cols; size_t split_stride; float scale0;
    __device__ __forceinline__ void operator()(const f32x4 (&acc)[2][2][4][2], const Unit& u, int wr, int wc, int fr, int fq) const {
        const int row0 = u.pm * BM + wr * 64 + fr; int colt = u.pn * BM; bf16_t* base = O;
        float sc = 1.f; if (split_cols) { const int t = colt / split_cols; base += (size_t)t * split_stride; colt -= t * split_cols; if (t == 0) sc = scale0; }
        const int col0 = colt + wc * 32 + 8 * fq, bcol0 = u.pn * BM + wc * 32 + 8 * fq;
        f32x4 bv[2][2];
#pragma unroll
        for (int bj = 0; bj < 2; ++bj)
#pragma unroll
            for (int n = 0; n < 2; ++n) bv[bj][n] = bias ? *(const f32x4*)(bias + bcol0 + bj * HALF + 4 * n) : (f32x4){0.f, 0.f, 0.f, 0.f};
#pragma unroll
        for (int ai = 0; ai < 2; ++ai)
#pragma unroll
            for (int m = 0; m < 4; ++m) { bf16_t* rowp = base + (size_t)(row0 + ai * HALF + m * 16) * ldc + col0;
#pragma unroll
                for (int bj = 0; bj < 2; ++bj) { f32x4 v0 = acc[ai][bj][m][0] + bv[bj][0], v1 = acc[ai][bj][m][1] + bv[bj][1];
                    if (ACT == 1) { f32x2 a = gelu_pk((f32x2){v0[0], v0[1]}), b = gelu_pk((f32x2){v0[2], v0[3]}), c = gelu_pk((f32x2){v1[0], v1[1]}), d = gelu_pk((f32x2){v1[2], v1[3]});
                        v0 = (f32x4){a.x, a.y, b.x, b.y}; v1 = (f32x4){c.x, c.y, d.x, d.y}; }
                    v0 = v0 * sc; v1 = v1 * sc; u32x4 w; w.x = cvt_pk_bf16(v0[0], v0[1]); w.y = cvt_pk_bf16(v0[2], v0[3]); w.z = cvt_pk_bf16(v1[0], v1[1]); w.w = cvt_pk_bf16(v1[2], v1[3]);
                    *(u32x4*)(rowp + bj * HALF) = w; } }
    }
};

struct EpiF32 {
    static constexpr bool PERM = false, AFTER_DRAIN = false;
    float* C; int ldc; const float* bias; const float* cscale; size_t kslab;
    __device__ __forceinline__ void operator()(const f32x4 (&acc)[2][2][4][2], const Unit& u, int wr, int wc, int fr, int fq) const {
        const int row0 = u.pm * BM + wr * 64 + fr, col0 = u.pn * BM + wc * 32 + 4 * fq;
        f32x4 bv[2][2], sv[2][2];
#pragma unroll
        for (int bj = 0; bj < 2; ++bj)
#pragma unroll
            for (int n = 0; n < 2; ++n) { bv[bj][n] = bias ? *(const f32x4*)(bias + col0 + bj * HALF + n * 16) : (f32x4){0.f, 0.f, 0.f, 0.f};
                sv[bj][n] = cscale ? *(const f32x4*)(cscale + col0 + bj * HALF + n * 16) : (f32x4){1.f, 1.f, 1.f, 1.f}; }
#pragma unroll
        for (int ai = 0; ai < 2; ++ai)
#pragma unroll
            for (int m = 0; m < 4; ++m) { float* rowp = C + (size_t)u.pk * kslab + (size_t)(row0 + ai * HALF + m * 16) * ldc + col0;
#pragma unroll
                for (int bj = 0; bj < 2; ++bj)
#pragma unroll
                    for (int n = 0; n < 2; ++n) *(f32x4*)(rowp + bj * HALF + n * 16) = (acc[ai][bj][m][n] + bv[bj][n]) * sv[bj][n]; }
    }
};
struct EpiQRope {
    static constexpr bool PERM = false, AFTER_DRAIN = false;
    bf16_t* O; const float* cosT; const float* sinT; bf16_t* QD;
    __device__ __forceinline__ void operator()(const f32x4 (&acc)[2][2][4][2], const Unit& u, int wr, int wc, int fr, int fq) const {
        const int row0 = u.pm * BM + wr * 64 + fr;
#pragma unroll
        for (int bj = 0; bj < 2; ++bj) {
            const int gb = u.pn * BM + bj * HALF + wc * 32; const bool rp = ((gb >> 5) % 3) == 2;
#pragma unroll
            for (int ai = 0; ai < 2; ++ai)
#pragma unroll
                for (int m = 0; m < 4; ++m) { const int row = row0 + ai * HALF + m * 16;
                    f32x4 v0 = acc[ai][bj][m][0], v1 = acc[ai][bj][m][1];
                    if (rp) { const int pos = row < 16384 ? (row & 8191) : 8192 + ((row - 16384) & 7);
                        const f32x4 c = *(const f32x4*)(cosT + pos * 16 + 4 * fq), s = *(const f32x4*)(sinT + pos * 16 + 4 * fq);
                        const f32x4 n0 = v0 * c - v1 * s, n1 = v1 * c + v0 * s; v0 = n0; v1 = n1; }
                    bf16_t* p = O + (size_t)row * 1536 + gb + 4 * fq;
                    typedef unsigned u32x2 __attribute__((ext_vector_type(2)));
                    u32x2 w0, w1; w0.x = cvt_pk_bf16(v0[0], v0[1]); w0.y = cvt_pk_bf16(v0[2], v0[3]); w1.x = cvt_pk_bf16(v1[0], v1[1]); w1.y = cvt_pk_bf16(v1[2], v1[3]);
                    *(u32x2*)p = w0; *(u32x2*)(p + 16) = w1;
                    if (rp && row >= 16384) { const int t = row - 16384, h = (gb >> 5) / 3; bf16_t* q = QD + ((size_t)(t >> 3) * 128 + (t & 7) * 16 + h) * 288 + 256 + 4 * fq; *(u32x2*)q = w0; *(u32x2*)(q + 16) = w1; } }
        }
    }
};


struct EpiQD {
    static constexpr bool PERM = true, AFTER_DRAIN = false;
    bf16_t* QD;
    __device__ __forceinline__ void operator()(const f32x4 (&acc)[2][2][4][2], const Unit& u, int wr, int wc, int fr, int fq) const {
        const int row0 = u.pm * BM + wr * 64 + fr, h = u.pn, col0 = wc * 32 + 8 * fq;
#pragma unroll
        for (int ai = 0; ai < 2; ++ai)
#pragma unroll
            for (int m = 0; m < 4; ++m) { const int t = row0 + ai * HALF + m * 16; bf16_t* base = QD + ((size_t)(t >> 3) * 128 + (t & 7) * 16 + h) * 288 + col0;
#pragma unroll
                for (int bj = 0; bj < 2; ++bj) { const f32x4 v0 = acc[ai][bj][m][0], v1 = acc[ai][bj][m][1];
                    u32x4 w; w.x = cvt_pk_bf16(v0[0], v0[1]); w.y = cvt_pk_bf16(v0[2], v0[3]); w.z = cvt_pk_bf16(v1[0], v1[1]); w.w = cvt_pk_bf16(v1[2], v1[3]);
                    *(u32x4*)(base + bj * HALF) = w; } }
    }
};
template <int S> struct SplitOrder {
    Unit u0; bool valid;
    __host__ __device__ void init(int N, int G_, int c_) { const int nN = N / BM; valid = c_ < 4 * nN * S; u0.pk = c_ % S; const int t = c_ / S; u0.pm = t & 3; u0.pn = t >> 2; u0.nt = 0; (void)G_; }
    __host__ __device__ bool next(int i, Unit& u) const { if (i > 0 || !valid) return false; u = u0; return true; }
    __device__ __forceinline__ void a_ready(const Unit&) const {}
    __device__ __forceinline__ void done(const Unit&) const {}
};


template <int S> struct HybridOrder {
    StaticOrder so; Unit us; bool has_s; int nt_full, nt_slice;
    __host__ __device__ void init(int Mp, int N, int Kfull, int G_, int c_) { so.init(Mp, N, G_, c_); nt_full = Kfull / BK; nt_slice = Kfull / S / BK;
        const int cs = G_ - 1 - c_, nN = N / BM; has_s = cs < 4 * nN * S; us.pk = cs % S; const int t = cs / S; us.pm = 64 + (t & 3); us.pn = t >> 2; us.nt = nt_slice; }
    __host__ __device__ bool next(int i, Unit& u) const { if (i == 0) { const bool ok = so.next(0, u); u.nt = nt_full; return ok; } if (i == 1 && has_s) { u = us; return true; } return false; }
    __device__ __forceinline__ void a_ready(const Unit&) const {}
    __device__ __forceinline__ void done(const Unit&) const {}
};
struct EpiHybrid {
    static constexpr bool PERM = true, AFTER_DRAIN = false;
    bf16_t* O; int ldc; float* slabs; size_t kslab;
    __device__ __forceinline__ void operator()(const f32x4 (&acc)[2][2][4][2], const Unit& u, int wr, int wc, int fr, int fq) const {
        const int col0 = u.pn * BM + wc * 32 + 8 * fq;
        if (u.pm < 64) { const int row0 = u.pm * BM + wr * 64 + fr;
#pragma unroll
            for (int ai = 0; ai < 2; ++ai)
#pragma unroll
                for (int m = 0; m < 4; ++m) { bf16_t* rowp = O + (size_t)(row0 + ai * HALF + m * 16) * ldc + col0;
#pragma unroll
                    for (int bj = 0; bj < 2; ++bj) { const f32x4 v0 = acc[ai][bj][m][0], v1 = acc[ai][bj][m][1];
                        u32x4 w; w.x = cvt_pk_bf16(v0[0], v0[1]); w.y = cvt_pk_bf16(v0[2], v0[3]); w.z = cvt_pk_bf16(v1[0], v1[1]); w.w = cvt_pk_bf16(v1[2], v1[3]);
                        *(u32x4*)(rowp + bj * HALF) = w; } }
        } else { const int row0 = (u.pm - 64) * BM + wr * 64 + fr; float* C = slabs + (size_t)u.pk * kslab;
#pragma unroll
            for (int ai = 0; ai < 2; ++ai)
#pragma unroll
                for (int m = 0; m < 4; ++m) { float* rowp = C + (size_t)(row0 + ai * HALF + m * 16) * 1024 + col0;
#pragma unroll
                    for (int bj = 0; bj < 2; ++bj) { *(f32x4*)(rowp + bj * HALF) = acc[ai][bj][m][0]; *(f32x4*)(rowp + bj * HALF + 4) = acc[ai][bj][m][1]; } }
        }
    }
};

template <class Epi, class Sched, bool ALIGN_EPI = false, bool SP2 = false>
__device__ __forceinline__ void gemm_phase(PG8_LAS unsigned char* lds, const Gemm g, const Sched& S, const Epi& E) {
    const int tid = opaque_tid(), wid = __builtin_amdgcn_readfirstlane(tid >> 6), lane = tid & 63, wr = wid >> 2, wc = wid & 3, fr = lane & 15, fq = lane >> 4;
    const int K = g.K; int nt = K / BK;
    unsigned voffA[2], voffB[2];
#pragma unroll
    for (int i = 0; i < 2; ++i) { int R, C; stage_rc(tid * 16 + i * 8192, R, C); const int Rb = Epi::PERM ? ((R & ~31) + perm32(R & 31)) : R;
        voffA[i] = (unsigned)(R * g.lda + C) * 2u; voffB[i] = (unsigned)(Rb * g.ldb + C) * 2u; }
    const size_t kstep = (size_t)(BK * 2);
    const size_t hstepA = (size_t)HALF * g.lda * 2, hstepB = (size_t)HALF * g.ldb * 2;
    const size_t tstepA = 2 * hstepA, tstepB = 2 * hstepB; const size_t gstepA = (size_t)g.agroup * 2, kstepS = (size_t)K * 2;
    const unsigned ldsw = (unsigned)wid * 1024u;
    const int aoff = lds_byte(wr * 64 + fr, fq * 8), boff = lds_byte(wc * 32 + fr, fq * 8);
#define PG8_SA(b, h) (((b) * 2 + (h)) * HTB)
#define PG8_SB(b, h) ((4 + (b) * 2 + (h)) * HTB)
#define PG8_STAGE(bufoff, gbase, voff) do { _Pragma("unroll") for (int _i = 0; _i < 2; ++_i) \
        __builtin_amdgcn_global_load_lds((const unsigned*)((const char*)(gbase) + (voff)[_i]), (PG8_LAS unsigned*)(lds + (bufoff) + ldsw + _i * 8192), 16, 0, 0); } while (0)
#define PG8_LDA(dst, b, h) do { _Pragma("unroll") for (int m = 0; m < 4; ++m) _Pragma("unroll") for (int k = 0; k < 2; ++k) dst[m][k] = *(const PG8_LAS bf16x8*)(lds + PG8_SA(b, h) + aoff + m * 2048 + k * 1024); } while (0)
#define PG8_LDB(dst, b, h) do { _Pragma("unroll") for (int n = 0; n < 2; ++n) _Pragma("unroll") for (int k = 0; k < 2; ++k) dst[n][k] = *(const PG8_LAS bf16x8*)(lds + PG8_SB(b, h) + boff + n * 2048 + k * 1024); } while (0)
#define PG8_MMA(ai, bj, At, Bt) do { __builtin_amdgcn_s_setprio(1); _Pragma("unroll") for (int m = 0; m < 4; ++m) _Pragma("unroll") for (int n = 0; n < 2; ++n) _Pragma("unroll") for (int k = 0; k < 2; ++k) \
        acc[ai][bj][m][n] = __builtin_amdgcn_mfma_f32_16x16x32_bf16(Bt[n][k], At[m][k], acc[ai][bj][m][n], 0, 0, 0); __builtin_amdgcn_s_setprio(0); } while (0)
#define PG8_WAIT_V(n) asm volatile("s_waitcnt vmcnt(" #n ")" ::: "memory")
#define PG8_WAIT_L(n) asm volatile("s_waitcnt lgkmcnt(" #n ")" ::: "memory")
#define PG8_BAR __builtin_amdgcn_s_barrier()
#define PG8_SCHED __builtin_amdgcn_sched_barrier(0)
    Unit cur, nxt; int ui = 0;
    if (!S.next(0, cur)) return;
    if (cur.nt > 0) nt = cur.nt;
    f32x4 acc[2][2][4][2];
#pragma unroll
    for (int a = 0; a < 2; ++a)
#pragma unroll
        for (int b = 0; b < 2; ++b)
#pragma unroll
            for (int m = 0; m < 4; ++m)
#pragma unroll
                for (int n = 0; n < 2; ++n) acc[a][b][m][n] = (f32x4){0.f, 0.f, 0.f, 0.f};
    bf16x8 At[4][2], B0[2][2], B1[2][2];
    const char* cA = (const char*)g.A + (size_t)cur.pm * tstepA + (size_t)cur.pn * gstepA + (size_t)cur.pk * kstepS; const char* cB = (const char*)g.Bt + (size_t)cur.pn * tstepB + (size_t)cur.pk * kstepS;
    S.a_ready(cur);
    if constexpr (SP2) {
        PG8_STAGE(PG8_SB(0, 0), cB, voffB); PG8_STAGE(PG8_SB(0, 1), cB + hstepB, voffB); PG8_STAGE(PG8_SA(0, 0), cA, voffA); PG8_STAGE(PG8_SA(0, 1), cA + hstepA, voffA);
        if (wr == 1) PG8_BAR;
        PG8_WAIT_V(2); PG8_BAR;
        PG8_STAGE(PG8_SB(1, 0), cB + kstep, voffB); PG8_STAGE(PG8_SA(1, 0), cA + kstep, voffA); PG8_STAGE(PG8_SB(1, 1), cB + hstepB + kstep, voffB);
        PG8_WAIT_V(6); PG8_BAR;
    } else {
        PG8_STAGE(PG8_SB(0, 0), cB, voffB); PG8_STAGE(PG8_SA(0, 0), cA, voffA); PG8_STAGE(PG8_SB(0, 1), cB + hstepB, voffB); PG8_STAGE(PG8_SA(0, 1), cA + hstepA, voffA);
        if (wr == 1) PG8_BAR;
        PG8_WAIT_V(4); PG8_BAR;
        PG8_STAGE(PG8_SB(1, 0), cB + kstep, voffB); PG8_STAGE(PG8_SA(1, 0), cA + kstep, voffA); PG8_STAGE(PG8_SB(1, 1), cB + hstepB + kstep, voffB);
        PG8_WAIT_V(6); PG8_BAR;
    }
    for (;;) {
        const bool has_next = S.next(ui + 1, nxt);
        const char* nA = has_next ? (const char*)g.A + (size_t)nxt.pm * tstepA + (size_t)nxt.pn * gstepA + (size_t)nxt.pk * kstepS : cA; const char* nB = has_next ? (const char*)g.Bt + (size_t)nxt.pn * tstepB + (size_t)nxt.pk * kstepS : cB;
        for (int t = 0; t < nt; t += 2) {
            const bool last = (t == nt - 2);
            const char* a1 = cA + (size_t)(t + 1) * kstep;
            const char* a2 = last ? nA : cA + (size_t)(t + 2) * kstep; const char* b2 = last ? nB : cB + (size_t)(t + 2) * kstep;
            const char* a3 = a2 + kstep; const char* b3 = b2 + kstep;
            if (last && has_next) S.a_ready(nxt);
            if constexpr (SP2) {
            PG8_LDB(B0, 0, 0); PG8_LDB(B1, 0, 1); PG8_SCHED; PG8_LDA(At, 0, 0); PG8_STAGE(PG8_SA(1, 1), a1 + hstepA, voffA);
            PG8_WAIT_V(8); PG8_WAIT_L(0); PG8_BAR; PG8_MMA(0, 0, At, B0); PG8_MMA(0, 1, At, B1); PG8_BAR; PG8_SCHED;
            PG8_LDA(At, 0, 1); PG8_STAGE(PG8_SB(0, 0), b2, voffB); PG8_STAGE(PG8_SB(0, 1), b2 + hstepB, voffB); PG8_STAGE(PG8_SA(0, 0), a2, voffA);
            PG8_WAIT_V(8); PG8_WAIT_L(0); PG8_BAR; PG8_MMA(1, 0, At, B0); PG8_MMA(1, 1, At, B1); PG8_BAR; PG8_SCHED;
            PG8_LDB(B0, 1, 0); PG8_LDB(B1, 1, 1); PG8_SCHED; PG8_LDA(At, 1, 0); PG8_STAGE(PG8_SA(0, 1), a2 + hstepA, voffA);
            PG8_WAIT_V(8); PG8_WAIT_L(0); PG8_BAR; PG8_MMA(0, 0, At, B0); PG8_MMA(0, 1, At, B1); PG8_BAR; PG8_SCHED;
            PG8_LDA(At, 1, 1); PG8_STAGE(PG8_SB(1, 0), b3, voffB); PG8_STAGE(PG8_SB(1, 1), b3 + hstepB, voffB); PG8_STAGE(PG8_SA(1, 0), a3, voffA);
            PG8_WAIT_V(8); PG8_WAIT_L(0); PG8_BAR; PG8_MMA(1, 0, At, B0); PG8_MMA(1, 1, At, B1); PG8_BAR; PG8_SCHED;
            } else {
            PG8_LDB(B0, 0, 0); PG8_SCHED; PG8_LDA(At, 0, 0); PG8_STAGE(PG8_SA(1, 1), a1 + hstepA, voffA);
            PG8_WAIT_L(8); PG8_BAR; PG8_WAIT_L(0); PG8_MMA(0, 0, At, B0); PG8_BAR; PG8_SCHED;
            PG8_LDB(B1, 0, 1); PG8_STAGE(PG8_SB(0, 0), b2, voffB);
            PG8_BAR; PG8_WAIT_L(0); PG8_MMA(0, 1, At, B1); PG8_BAR;
            PG8_LDA(At, 0, 1); PG8_STAGE(PG8_SA(0, 0), a2, voffA);
            PG8_BAR; PG8_WAIT_L(0); PG8_MMA(1, 0, At, B0); PG8_BAR; PG8_SCHED;
            PG8_STAGE(PG8_SB(0, 1), b2 + hstepB, voffB);
            PG8_WAIT_V(6); PG8_BAR; PG8_MMA(1, 1, At, B1); PG8_BAR;
            PG8_LDB(B0, 1, 0); PG8_SCHED; PG8_LDA(At, 1, 0); PG8_STAGE(PG8_SA(0, 1), a2 + hstepA, voffA);
            PG8_WAIT_L(8); PG8_BAR; PG8_WAIT_L(0); PG8_MMA(0, 0, At, B0); PG8_BAR; PG8_SCHED;
            PG8_LDB(B1, 1, 1); PG8_STAGE(PG8_SB(1, 0), b3, voffB);
            PG8_BAR; PG8_WAIT_L(0); PG8_MMA(0, 1, At, B1); PG8_BAR;
            PG8_LDA(At, 1, 1); PG8_STAGE(PG8_SA(1, 0), a3, voffA);
            PG8_BAR; PG8_WAIT_L(0); PG8_MMA(1, 0, At, B0); PG8_BAR; PG8_SCHED;
            PG8_STAGE(PG8_SB(1, 1), b3 + hstepB, voffB);
            PG8_WAIT_V(6); PG8_BAR; PG8_MMA(1, 1, At, B1); PG8_BAR;
            }
        }
        if constexpr (ALIGN_EPI) { if (wr == 0) PG8_BAR; }
        if constexpr (!Epi::AFTER_DRAIN) { E(acc, cur, wr, wc, fr, fq); S.done(cur); }
        if (!has_next) break;
#pragma unroll
        for (int a = 0; a < 2; ++a)
#pragma unroll
            for (int b = 0; b < 2; ++b)
#pragma unroll
                for (int m = 0; m < 4; ++m)
#pragma unroll
                    for (int n = 0; n < 2; ++n) acc[a][b][m][n] = (f32x4){0.f, 0.f, 0.f, 0.f};
        cur = nxt; cA = nA; cB = nB; ++ui; nt = (cur.nt > 0) ? cur.nt : K / BK;
        if constexpr (ALIGN_EPI) { if (wr == 1) PG8_BAR; }
    }
    PG8_WAIT_V(0);
    if constexpr (!ALIGN_EPI) { if (wr == 0) PG8_BAR; }
    PG8_BAR;
    if constexpr (Epi::AFTER_DRAIN) { E.fused(acc, cur, wr, wc, fr, fq, lds, wid, lane); S.done(cur); }
#undef PG8_SA
#undef PG8_SB
#undef PG8_STAGE
#undef PG8_LDA
#undef PG8_LDB
#undef PG8_MMA
#undef PG8_WAIT_V
#undef PG8_WAIT_L
#undef PG8_BAR
#undef PG8_SCHED
}
}

constexpr int NWAVES = 8;
constexpr int DM = 1024, TSEQ = 8192, NPR = 16384, NSR = 1024, NR = NPR + NSR;
constexpr int NDB = 128, NDS = 8, NH = 16, QL = 512, KVL = 256, RD = 32, FF = 2816, FF2 = 5632, NPAGE = 64;
constexpr float EPS = 1e-6f;
constexpr float SC2 = 0.10206207261596575f * 1.4426950408889634f;
constexpr size_t OUT_KVP = 17825792, OUT_KRP = 22020096, OUT_KVS = 22544384, OUT_KRS = 22806528, OUT_PSP = 22839296, OUT_PSS = 22870016, OUT_CSP = 24836096, OUT_CSS = 24881152, OUT_TOTAL = 27764736;
constexpr size_t MiB = 1u << 20;
constexpr size_t WS_CTL = 0, CTL_ZERO_BYTES = 1 * MiB;
constexpr size_t WS_COS = 1 * MiB, WS_SIN = 2 * MiB, WS_SILUC = 3 * MiB, WS_MOD = 4 * MiB, WS_ADAT = 16 * MiB, WS_WDQKV = 40 * MiB, WS_WUQ = 42 * MiB, WS_WKVUP = 44 * MiB, WS_WO = 45 * MiB,
                 WS_POOLT = 47 * MiB, WS_WUP = 48 * MiB, WS_WDOWN = 70 * MiB, WS_HN = 82 * MiB, WS_TMP = 116 * MiB, WS_CQ = 184 * MiB, WS_CKV = 201 * MiB, WS_KRB = 210 * MiB, WS_QP = 212 * MiB,
                 WS_KN = 264 * MiB, WS_VV = 296 * MiB, WS_O = 328 * MiB, WS_QD = 362 * MiB, WS_DPART = 372 * MiB, WS_DML = 404 * MiB, WS_U = 406 * MiB, WS_A2 = 594 * MiB, WS_H1 = 688 * MiB,
                 WS_POOLED = 756 * MiB, WS_XB = 722 * MiB, WS_WABS = 790 * MiB, WS_TMPS = 794 * MiB, WS_END = 840 * MiB;
constexpr int CW_BAR = 4096;
constexpr int RING_BYTES = 151552, LDSCTL_OFF = RING_BYTES, MISC_OFF = LDSCTL_OFF + 320, LDS_BYTES = 153600;

#define GAS __attribute__((address_space(1)))
#define LAS __attribute__((address_space(3)))
typedef unsigned short bf16;
typedef unsigned v4u __attribute__((ext_vector_type(4)));
typedef unsigned v2u __attribute__((ext_vector_type(2)));
typedef float f32x4 __attribute__((ext_vector_type(4)));
typedef float f32x2 __attribute__((ext_vector_type(2)));
typedef float f32x16 __attribute__((ext_vector_type(16)));
typedef short bf16x8 __attribute__((ext_vector_type(8)));
typedef short s16x4 __attribute__((ext_vector_type(4)));
typedef GAS unsigned gu32;
#define RLX_AGENT __ATOMIC_RELAXED, __HIP_MEMORY_SCOPE_AGENT
#define LDS_WAIT() asm volatile("s_waitcnt lgkmcnt(0)" ::: "memory")
#define VM_WAIT() asm volatile("s_waitcnt vmcnt(0)" ::: "memory")
__device__ __forceinline__ unsigned f2bf(float f) { unsigned u = __builtin_bit_cast(unsigned, f); return (u + 0x7fffu + ((u >> 16) & 1u)) >> 16; }

__device__ __forceinline__ float bf2f(unsigned h) { return __builtin_bit_cast(float, h << 16); }
__device__ __forceinline__ float bflo(unsigned w) { return __builtin_bit_cast(float, w << 16); }
__device__ __forceinline__ float bfhi(unsigned w) { return __builtin_bit_cast(float, w & 0xffff0000u); }
typedef __bf16 bf16x2_t __attribute__((ext_vector_type(2)));
__device__ __forceinline__ unsigned cvtpk(float lo, float hi) { const f32x2 v = {lo, hi}; const bf16x2_t b = __builtin_convertvector(v, bf16x2_t); return __builtin_bit_cast(unsigned, b); }
__device__ __forceinline__ unsigned pk2(float lo, float hi) { return cvtpk(lo, hi); }

#define XB_TMO      128
#define XB_XCNT(j)  (256  + 64 * (j))
#define XB_XSUB(j)  (1280 + 64 * (j))
#define XB_XGEN(j)  (2304 + 64 * (j))
#define XB_TOP      3328
#define XB_TOPGEN   3392
#define XCD_BAR_WORDS 3456
#define XB_SPIN_CAP (1u << 18)

__device__ __forceinline__ unsigned xb_ld(unsigned* p)              { return __hip_atomic_load(p, __ATOMIC_RELAXED, __HIP_MEMORY_SCOPE_AGENT); }
__device__ __forceinline__ unsigned xb_add(unsigned* p, unsigned v) { return __hip_atomic_fetch_add(p, v, __ATOMIC_RELAXED, __HIP_MEMORY_SCOPE_AGENT); }
__device__ __forceinline__ unsigned xb_xcc_id() { return (unsigned)__builtin_amdgcn_s_getreg((3 << 11) | 20) & 0xFu; }
#define XB_SPIN(cond, bar) do { unsigned _sp = 0; while (cond) { __builtin_amdgcn_s_sleep(1); \
    if ((++_sp & 255u) == 0u) { if (xb_ld(&(bar)[XB_TMO])) break; if (_sp > XB_SPIN_CAP) { atomicAdd(&(bar)[XB_TMO], 1u); break; } } } } while (0)

struct XcdBarrier {
    unsigned* bar; unsigned x;
    volatile LAS unsigned* st;
};

__device__ __forceinline__ XcdBarrier xcd_barrier_post(unsigned* bar, volatile LAS unsigned* st) {
    XcdBarrier b; b.bar = bar; b.x = xb_xcc_id(); b.st = st;
    if (threadIdx.x == 0) (void)xb_add(&bar[XB_XCNT(b.x)], 1u);
    return b;
}
__device__ __forceinline__ void xcd_barrier_complete(unsigned* bar, unsigned x, unsigned& nloc, unsigned& nx) {
    const unsigned G = gridDim.x * gridDim.y * gridDim.z;
    unsigned sum, cnt, mine, sp = 0u;
    for (;;) {
        sum = 0u; cnt = 0u; mine = 0u;
#pragma unroll
        for (unsigned j = 0; j < 16; ++j) { const unsigned c = xb_ld(&bar[XB_XCNT(j)]); sum += c; cnt += (c > 0u) ? 1u : 0u; mine = (j == x) ? c : mine; }
        if (sum == G) break;
        __builtin_amdgcn_s_sleep(1);
        if ((++sp & 255u) == 0u) { if (xb_ld(&bar[XB_TMO])) break; if (sp > XB_SPIN_CAP) { atomicAdd(&bar[XB_TMO], 1u); break; } }
    }
    nloc = mine > 0u ? mine : 1u; nx = cnt > 0u ? cnt : 1u;
}

__device__ __forceinline__ void xcd_barrier(const XcdBarrier& b) {
    asm volatile("s_waitcnt vmcnt(0)" ::: "memory");
    __syncthreads();
    if (threadIdx.x == 0) {
        unsigned* bar = b.bar;
        __builtin_amdgcn_s_waitcnt(0);
        unsigned nloc = b.st[0], nx = b.st[1];
        if (nloc == 0u) { xcd_barrier_complete(bar, b.x, nloc, nx); b.st[0] = nloc; b.st[1] = nx; }
        const unsigned old = xb_add(&bar[XB_XSUB(b.x)], 1u);
        const unsigned gen = old / nloc;
        if (old + 1u == (gen + 1u) * nloc) {
            __builtin_amdgcn_fence(__ATOMIC_RELEASE, "agent");
            asm volatile("s_waitcnt vmcnt(0)" ::: "memory");
            const unsigned og = xb_add(&bar[XB_TOP], 1u);
            const unsigned tg = og / nx;
            if (og + 1u == (tg + 1u) * nx) xb_add(&bar[XB_TOPGEN], 1u);
            else XB_SPIN(xb_ld(&bar[XB_TOPGEN]) == tg, bar);
            __builtin_amdgcn_fence(__ATOMIC_ACQUIRE, "agent");
            xb_add(&bar[XB_XGEN(b.x)], 1u);
            asm volatile("s_waitcnt vmcnt(0)" ::: "memory");
        } else {
            XB_SPIN(xb_ld(&bar[XB_XGEN(b.x)]) == gen, bar);
            __builtin_amdgcn_fence(__ATOMIC_ACQUIRE, "agent");
            asm volatile("s_waitcnt vmcnt(0)" ::: "memory");
        }
    }
    __syncthreads();
}

struct Args { const void* in[29]; float* out; unsigned char* ws; int ph_lo, ph_hi; };
struct Frame { LAS unsigned char* lds; volatile LAS unsigned* MISC; gu32* ctl; int tid, lane, wave, vcu, G; };

__device__ __forceinline__ float wave_sum(float v) {
#pragma unroll
    for (int o = 1; o < 64; o <<= 1) v += __shfl_xor(v, o);
    return v;
}
__device__ __forceinline__ float dot4(f32x4 a, f32x4 b) { return (a.x * b.x + a.y * b.y) + (a.z * b.z + a.w * b.w); }

__device__ __forceinline__ void p0_transpose_item(const float* W, int K, int N, bf16* WT, int row_off, LAS float* scr, int item, int lane) {
    const int nblk = N / 32, kb = item / nblk, nb = item % nblk, k0 = 64 * kb, n0 = 32 * nb;
#pragma unroll 8
    for (int i = 0; i < 32; ++i) { const int kk = 2 * i + (lane >> 5); scr[kk * 33 + (lane & 31)] = W[(size_t)(k0 + kk) * N + n0 + (lane & 31)]; }
    LDS_WAIT(); asm volatile("" ::: "memory");
    const int c = lane & 7;
#pragma unroll
    for (int j = 0; j < 4; ++j) { const int n = (lane >> 3) + 8 * j; const LAS float* s = scr + (8 * c) * 33 + n;
        v4u o; o.x = pk2(s[0 * 33], s[1 * 33]); o.y = pk2(s[2 * 33], s[3 * 33]); o.z = pk2(s[4 * 33], s[5 * 33]); o.w = pk2(s[6 * 33], s[7 * 33]);
        *(GAS v4u*)(WT + (size_t)(row_off + n0 + n) * K + k0 + 8 * c) = o; }
    LDS_WAIT(); asm volatile("" ::: "memory");
}

#ifndef DEFER_ALL
#define DEFER_ALL 0
#endif
template <int PART>
__device__ __forceinline__ void ph_prologue(const Frame& F, const Args& a, int wv, int nwv) {
    LAS float* scr = (LAS float*)(F.lds + F.wave * 16384);
    unsigned char* ws = a.ws;
    const int gw = wv, NGW = nwv;
    constexpr int I_ADA = 16 * 192, I_DQ = 16 * 16, I_DKV = 16 * 9, I_UQ = 8 * 48, I_UK = 4 * 32, I_WO = 16 * 32, I_POOL = 4 * 8, I_UP = 16 * 176, I_DOWN = 44 * 32;
    constexpr int NITEMS = 2 * I_ADA + I_DQ + I_DKV + I_UQ + 2 * I_UK + I_WO + 4 * I_POOL + 2 * I_UP + 2 * I_DOWN;
    constexpr int SPLIT = 2 * I_ADA + (DEFER_ALL ? 0 : 3584);
    for (int it = (PART == 0 ? gw : SPLIT + gw); it < (PART == 0 ? SPLIT : NITEMS); it += NGW) {
        int r = it;
        if (r < 2 * I_ADA) { const int l = r / I_ADA; p0_transpose_item((const float*)a.in[9] + (size_t)l * 1024 * 6144, 1024, 6144, (bf16*)(ws + WS_ADAT), l * 6144, scr, r % I_ADA, F.lane); continue; } r -= 2 * I_ADA;
        if (r < I_DQ) { p0_transpose_item((const float*)a.in[15], 1024, 512, (bf16*)(ws + WS_WDQKV), 0, scr, r, F.lane); continue; } r -= I_DQ;
        if (r < I_DKV) { p0_transpose_item((const float*)a.in[18], 1024, 288, (bf16*)(ws + WS_WDQKV), 512, scr, r, F.lane); continue; } r -= I_DKV;
        if (r < I_UQ) { p0_transpose_item((const float*)a.in[17], 512, 1536, (bf16*)(ws + WS_WUQ), 0, scr, r, F.lane); continue; } r -= I_UQ;
        if (r < I_UK) { p0_transpose_item((const float*)a.in[20], 256, 1024, (bf16*)(ws + WS_WKVUP), 0, scr, r, F.lane); continue; } r -= I_UK;
        if (r < I_UK) { p0_transpose_item((const float*)a.in[21], 256, 1024, (bf16*)(ws + WS_WKVUP), 1024, scr, r, F.lane); continue; } r -= I_UK;
        if (r < I_WO) { p0_transpose_item((const float*)a.in[22], 1024, 1024, (bf16*)(ws + WS_WO), 0, scr, r, F.lane); continue; } r -= I_WO;
        if (r < 4 * I_POOL) { const int g = r / I_POOL; p0_transpose_item((const float*)a.in[23] + (size_t)g * 65536, 256, 256, (bf16*)(ws + WS_POOLT), g * 256, scr, r % I_POOL, F.lane); continue; } r -= 4 * I_POOL;
        if (r < 2 * I_UP) { const int l = r / I_UP; p0_transpose_item((const float*)a.in[25] + (size_t)l * 1024 * FF2, 1024, FF2, (bf16*)(ws + WS_WUP) + (size_t)l * FF2 * 1024, 0, scr, r % I_UP, F.lane); continue; } r -= 2 * I_UP;
        { const int l = r / I_DOWN; p0_transpose_item((const float*)a.in[28] + (size_t)l * FF * 1024, FF, 1024, (bf16*)(ws + WS_WDOWN) + (size_t)l * 1024 * FF, 0, scr, r % I_DOWN, F.lane); }
    }
    if (PART == 1)
    for (int it = NGW - 1 - gw; it < 512; it += NGW) { const int h = it >> 5, kb = (it >> 3) & 3, cb = it & 7; const float* wuq = (const float*)a.in[17]; const float* wuk = (const float*)a.in[20];
#pragma unroll 8
        for (int i = 0; i < 64; ++i) scr[i * 64 + F.lane] = wuq[(size_t)(cb * 64 + i) * 1536 + h * 96 + F.lane];
        f32x4 wk[16];
#pragma unroll
        for (int n = 0; n < 16; ++n) wk[n] = *(const f32x4*)(wuk + (size_t)(kb * 64 + F.lane) * 1024 + h * 64 + 4 * n);
        LDS_WAIT(); asm volatile("" ::: "memory");
#pragma unroll 1
        for (int c2 = 0; c2 < 32; ++c2) { float s0 = 0.f, s1 = 0.f; const LAS float* q = scr + c2 * 128;
#pragma unroll
            for (int n = 0; n < 16; ++n) { s0 += dot4(wk[n], *(const LAS f32x4*)(q + 4 * n)); s1 += dot4(wk[n], *(const LAS f32x4*)(q + 64 + 4 * n)); }
            *(GAS unsigned*)((bf16*)(ws + WS_WABS) + (size_t)(h * 256 + kb * 64 + F.lane) * 512 + cb * 64 + c2 * 2) = pk2(s0, s1); }
        LDS_WAIT(); asm volatile("" ::: "memory");
    }
    const int gt = gw * 64 + F.lane, NGT = NGW * 64;
    if (PART == 1) for (int i = gt; i < 224 * 128; i += NGT) *(GAS v4u*)(ws + WS_WDQKV + (size_t)800 * 2048 + (size_t)i * 16) = (v4u){0u, 0u, 0u, 0u};
    if (PART == 1) return;
    for (int i = gt; i < 256 * 128; i += NGT) { const int r = i >> 7, d = (i & 127) * 8; v4u o = (v4u){0u, 0u, 0u, 0u};
        if (r < 130) { const float* c = r < 2 ? (const float*)a.in[7] + r * 1024 + d : (const float*)a.in[8] + (r - 2) * 1024 + d; float v[8];
#pragma unroll
            for (int e = 0; e < 8; ++e) { const float x = c[e]; v[e] = x / (1.f + __expf(-x)); }
            o.x = pk2(v[0], v[1]); o.y = pk2(v[2], v[3]); o.z = pk2(v[4], v[5]); o.w = pk2(v[6], v[7]); }
        *(GAS v4u*)(ws + WS_SILUC + (size_t)i * 16) = o; }
    for (int i = gt; i < 8200 * 16; i += NGT) { const int pos = i >> 4, k = i & 15;
        const double inv = exp2(-(double)k * (13.287712379549449 / 16.0)); const double ang = (double)pos * inv;
        const double kk = rint(ang * 0.15915494309189535); double r = fma(-kk, 6.283185307179586, ang); r = fma(-kk, 2.4492935982947064e-16, r);
        const double r2 = r * r; double s = 1.0, c = 1.0;
#pragma unroll
        for (int n = 13; n >= 1; --n) { s = 1.0 - s * r2 * (1.0 / ((2.0 * n) * (2.0 * n + 1.0))); c = 1.0 - c * r2 * (1.0 / ((2.0 * n - 1.0) * (2.0 * n))); }
        s *= r;
        ((float*)(ws + WS_COS))[i] = (float)c; ((float*)(ws + WS_SIN))[i] = (float)s; }
}

template <bool HAS_Y>
__device__ __forceinline__ void rowop_load(int row, int lane, const float* xa, const float* xb, const bf16* XB, const bf16* Yb, bool has_ys, const f32x4 (&ysc)[4], const float* YS, int nsplit, f32x4 (&x)[4], f32x4 (&y)[4]) {
    if (XB) {
#pragma unroll
        for (int j = 0; j < 4; ++j) { const v2u v = *(const v2u*)(XB + (size_t)row * DM + 4 * lane + 256 * j); x[j] = (f32x4){bflo(v.x), bfhi(v.x), bflo(v.y), bfhi(v.y)}; }
    } else { const float* xr = row < NPR ? xa + (size_t)row * DM : xb + (size_t)(row - NPR) * DM;
#pragma unroll
        for (int j = 0; j < 4; ++j) x[j] = *(const f32x4*)(xr + 4 * lane + 256 * j); }
    if (HAS_Y) {
#pragma unroll
        for (int j = 0; j < 4; ++j) {
            if (row < NPR || nsplit == 0) { const v2u v = *(const v2u*)(Yb + (size_t)row * DM + 4 * lane + 256 * j); y[j] = (f32x4){bflo(v.x), bfhi(v.x), bflo(v.y), bfhi(v.y)}; }
            else { y[j] = (f32x4){0.f, 0.f, 0.f, 0.f};
                for (int s = 0; s < nsplit; ++s) y[j] = y[j] + *(const f32x4*)(YS + ((size_t)s * NSR + (row - NPR)) * DM + 4 * lane + 256 * j); }
            if (has_ys) y[j] = y[j] * ysc[j]; }
    }
}
struct ModVec { f32x4 g[4], sc[4], sh[4]; int bi; };
template <bool HAS_Y, int OUTM>
__device__ __forceinline__ void modvec_load(ModVec& mv, int bi, int lane, const float* MOD, int og, int osh, int osc) {
    if (bi == mv.bi) return;
    const float* modr = MOD + (size_t)bi * 12288; mv.bi = bi;
#pragma unroll
    for (int j = 0; j < 4; ++j) { const int d = 4 * lane + 256 * j;
        if (HAS_Y) mv.g[j] = *(const f32x4*)(modr + og + d);
        if (OUTM != 0) { mv.sc[j] = *(const f32x4*)(modr + osc + d); mv.sh[j] = *(const f32x4*)(modr + osh + d); } }
}
template <bool HAS_Y, int OUTM>
__device__ __forceinline__ void rowop_finish(int row, int lane, f32x4 (&x)[4], const f32x4 (&y)[4], float* X, bf16* XBo, const ModVec& mv, const f32x4 (&wpo)[4], const f32x4 (&wpr)[4], bf16* HN, float* out) {
    if (HAS_Y) {
        float ss = 0.f;
#pragma unroll
        for (int j = 0; j < 4; ++j) ss += dot4(y[j], y[j]);
        const float r = 1.f / sqrtf(wave_sum(ss) * (1.f / DM) + EPS);
#pragma unroll
        for (int j = 0; j < 4; ++j) {
            x[j] = x[j] + mv.g[j] * (y[j] * r * wpo[j]);
            if (XBo) { v2u o; o.x = pk2(x[j].x, x[j].y); o.y = pk2(x[j].z, x[j].w); *(v2u*)(XBo + (size_t)row * DM + 4 * lane + 256 * j) = o; x[j] = (f32x4){bflo(o.x), bfhi(o.x), bflo(o.y), bfhi(o.y)}; }
            else *(f32x4*)(X + (size_t)row * DM + 4 * lane + 256 * j) = x[j]; }
    }
    if (OUTM != 0) {
        float ss = 0.f;
#pragma unroll
        for (int j = 0; j < 4; ++j) ss += dot4(x[j], x[j]);
        const float r = 1.f / sqrtf(wave_sum(ss) * (1.f / DM) + EPS);
        float* st = nullptr;
        if (OUTM == 2) { if (row >= NPR) st = out + OUT_PSS + ((size_t)((row - NPR) >> 3) * 15 + 7 + ((row - NPR) & 7)) * DM;
                         else if ((row & 8191) >= 8177) st = out + OUT_PSP + ((size_t)(row >> 13) * 15 + ((row & 8191) - 8177)) * DM; }
#pragma unroll
        for (int j = 0; j < 4; ++j) { const int d = 4 * lane + 256 * j;
            const f32x4 h = (x[j] * r * wpr[j]) * (mv.sc[j] + 1.f) + mv.sh[j];
            v2u o; o.x = pk2(h.x, h.y); o.y = pk2(h.z, h.w); *(v2u*)(HN + (size_t)row * DM + d) = o;
            if (OUTM == 2 && st) *(f32x4*)(st + d) = h; }
    }
}
template <bool HAS_Y, int OUTM>
__device__ __forceinline__ void ph_rowop(const Frame& F, const float* xa, const float* xb, float* X, const bf16* Yb, const float* MOD, const float* yscale, int og, const float* wpost,
                                         int osh, int osc, const float* wpre, bf16* HN, float* out, const float* YS = nullptr, int nsplit = 0, const bf16* XBi = nullptr, bf16* XBo = nullptr) {
    const int gw = F.vcu * NWAVES + F.wave, NGW = F.G * NWAVES, lane = F.lane;
    f32x4 wpo[4], wpr[4];
#pragma unroll
    for (int j = 0; j < 4; ++j) { wpo[j] = HAS_Y ? *(const f32x4*)(wpost + 4 * lane + 256 * j) : (f32x4){0.f, 0.f, 0.f, 0.f}; wpr[j] = OUTM != 0 ? *(const f32x4*)(wpre + 4 * lane + 256 * j) : (f32x4){0.f, 0.f, 0.f, 0.f}; }
    ModVec mv; mv.bi = -1;
    f32x4 ysc[4]; const bool has_ys = yscale != nullptr;
#pragma unroll
    for (int j = 0; j < 4; ++j) ysc[j] = has_ys ? *(const f32x4*)(yscale + 4 * lane + 256 * j) : (f32x4){1.f, 1.f, 1.f, 1.f};
    for (int row = gw; row < NR; row += 2 * NGW) {
        const int row2 = row + NGW; const bool two = row2 < NR;
        f32x4 x0[4], y0[4], x1[4], y1[4];
        rowop_load<HAS_Y>(row, lane, xa, xb, XBi, Yb, has_ys, ysc, YS, nsplit, x0, y0);
        if (two) rowop_load<HAS_Y>(row2, lane, xa, xb, XBi, Yb, has_ys, ysc, YS, nsplit, x1, y1);
        modvec_load<HAS_Y, OUTM>(mv, row < NPR ? (row >> 13) : 2 + ((row - NPR) >> 3), lane, MOD, og, osh, osc);
        rowop_finish<HAS_Y, OUTM>(row, lane, x0, y0, X, XBo, mv, wpo, wpr, HN, out);
        if (two) { modvec_load<HAS_Y, OUTM>(mv, row2 < NPR ? (row2 >> 13) : 2 + ((row2 - NPR) >> 3), lane, MOD, og, osh, osc);
                   rowop_finish<HAS_Y, OUTM>(row2, lane, x1, y1, X, XBo, mv, wpo, wpr, HN, out); }
    }
}

__device__ __forceinline__ void ph_qkvpost(const Frame& F, const Args& a) {
    unsigned char* ws = a.ws; const float* TMP = (const float*)(ws + WS_TMP); const float* qn = (const float*)a.in[16]; const float* kvn = (const float*)a.in[19];
    const float* cosT = (const float*)(ws + WS_COS); const float* sinT = (const float*)(ws + WS_SIN);
    bf16* CQ = (bf16*)(ws + WS_CQ); bf16* CKV = (bf16*)(ws + WS_CKV); bf16* KRB = (bf16*)(ws + WS_KRB); float* out = a.out;
    const int gw = F.vcu * NWAVES + F.wave, NGW = F.G * NWAVES, lane = F.lane;
    const f32x4 w0 = *(const f32x4*)(qn + 4 * lane), w1 = *(const f32x4*)(qn + 256 + 4 * lane), wk = *(const f32x4*)(kvn + 4 * lane);
    for (int row = gw; row < NR; row += NGW) {
        const float* t = (const float*)(ws + WS_TMPS) + (size_t)(row - NPR) * 1024;
        f32x4 a0, a1, kk; float x1 = 0.f, x2 = 0.f;
        if (row < NPR) { const bf16* tb = (const bf16*)TMP + (size_t)row * 1024; const v2u v0 = *(const v2u*)(tb + 4 * lane), v1 = *(const v2u*)(tb + 256 + 4 * lane), v2 = *(const v2u*)(tb + 512 + 4 * lane);
            a0 = (f32x4){bflo(v0.x), bfhi(v0.x), bflo(v0.y), bfhi(v0.y)}; a1 = (f32x4){bflo(v1.x), bfhi(v1.x), bflo(v1.y), bfhi(v1.y)}; kk = (f32x4){bflo(v2.x), bfhi(v2.x), bflo(v2.y), bfhi(v2.y)};
            if (lane < 16) { x1 = bf2f(tb[768 + lane]); x2 = bf2f(tb[784 + lane]); } }
        else { a0 = *(const f32x4*)(t + 4 * lane); a1 = *(const f32x4*)(t + 256 + 4 * lane); kk = *(const f32x4*)(t + 512 + 4 * lane); if (lane < 16) { x1 = t[768 + lane]; x2 = t[784 + lane]; } }
        if (row >= NPR) {
#pragma unroll
            for (int s = 1; s < 4; ++s) { const float* ts = t + (size_t)s * NSR * 1024; a0 = a0 + *(const f32x4*)(ts + 4 * lane); a1 = a1 + *(const f32x4*)(ts + 256 + 4 * lane); kk = kk + *(const f32x4*)(ts + 512 + 4 * lane);
                if (lane < 16) { x1 += ts[768 + lane]; x2 += ts[784 + lane]; } } }
        const float rq = 1.f / sqrtf(wave_sum(dot4(a0, a0) + dot4(a1, a1)) * (1.f / QL) + EPS);
        const float rk = 1.f / sqrtf(wave_sum(dot4(kk, kk)) * (1.f / KVL) + EPS);
        const f32x4 c0 = a0 * rq * w0, c1 = a1 * rq * w1, ck = kk * rk * wk;
        v2u o; o.x = pk2(c0.x, c0.y); o.y = pk2(c0.z, c0.w); *(v2u*)(CQ + (size_t)row * QL + 4 * lane) = o;
        o.x = pk2(c1.x, c1.y); o.y = pk2(c1.z, c1.w); *(v2u*)(CQ + (size_t)row * QL + 256 + 4 * lane) = o;
        float* okv = row < NPR ? out + OUT_KVP + (size_t)row * KVL : out + OUT_KVS + (size_t)(row - NPR) * KVL;
        *(f32x4*)(okv + 4 * lane) = ck;
        o.x = pk2(ck.x, ck.y); o.y = pk2(ck.z, ck.w); *(v2u*)(CKV + (size_t)row * KVL + 4 * lane) = o;
        if (lane < 16) { const int pos = row < NPR ? (row & 8191) : 8192 + ((row - NPR) & 7);
            const float c = cosT[pos * 16 + lane], s = sinT[pos * 16 + lane]; const float o1 = x1 * c - x2 * s, o2 = x2 * c + x1 * s;
            float* okr = row < NPR ? out + OUT_KRP + (size_t)row * RD : out + OUT_KRS + (size_t)(row - NPR) * RD;
            okr[lane] = o1; okr[16 + lane] = o2; KRB[(size_t)row * RD + lane] = (bf16)f2bf(o1); KRB[(size_t)row * RD + 16 + lane] = (bf16)f2bf(o2); }
    }
}

__device__ __forceinline__ s16x4 trrd(LAS unsigned char* p) { typedef short v4i16_t __attribute__((ext_vector_type(4))); return __builtin_bit_cast(s16x4, __builtin_amdgcn_ds_read_tr16_b64_v4i16((LAS v4i16_t*)p)); }
__device__ __forceinline__ bf16x8 cat8(s16x4 lo, s16x4 hi) { return (bf16x8){lo[0], lo[1], lo[2], lo[3], hi[0], hi[1], hi[2], hi[3]}; }
__device__ __forceinline__ bf16x8 pack8(float a0, float a1, float a2, float a3, float a4, float a5, float a6, float a7) {
    v4u w; w.x = cvtpk(a0, a1); w.y = cvtpk(a2, a3); w.z = cvtpk(a4, a5); w.w = cvtpk(a6, a7); return __builtin_bit_cast(bf16x8, w); }
#define EXP2(x) __builtin_amdgcn_exp2f(x)

__device__ __forceinline__ float max3f(float a, float b, float c) { float r; asm volatile("v_max3_f32 %0, %1, %2, %3" : "=v"(r) : "v"(a), "v"(b), "v"(c)); return r; }
__device__ __forceinline__ float hmax32(float v) { auto rr = __builtin_amdgcn_permlane32_swap(__float_as_uint(v), __float_as_uint(v), false, false); return fmaxf(__uint_as_float(rr[0]), __uint_as_float(rr[1])); }
__device__ __forceinline__ void pattn_unit(LAS unsigned char* lds, const bf16* QP, const bf16* KN, const bf16* KRB, const bf16* VV, bf16* O, int b, int h, int qb) {
    const int tid = opaque_tid(), lane = tid & 63, wid = __builtin_amdgcn_readfirstlane(tid >> 6), r32 = lane & 31, hi = lane >> 5;
    constexpr int KP = 208, VP = 192, KBUF = 64 * KP, VBUF = 64 * VP, OFF_V = 2 * KBUF;
    const size_t rowb = (size_t)b * TSEQ; const int qw = qb * 256 + wid * 32;
    constexpr int OFF_Q = OFF_V + 2 * VBUF;
    LAS unsigned char* Qw = lds + OFF_Q + (wid * 32 + r32) * KP + hi * 16;
    { const bf16* qp = QP + (rowb + qw + r32) * 1536 + h * 96 + hi * 8;
#pragma unroll
      for (int d0 = 0; d0 < 6; ++d0) *(LAS bf16x8*)(Qw + d0 * 32) = *(const bf16x8*)(qp + d0 * 16); }
    const int lrow = tid >> 3, lch = tid & 7, rrow = (tid & 255) >> 2, rch = tid & 3; const bool hasr = tid < 256;
    const bf16* gkn = KN + (rowb + lrow) * 1024 + h * 64 + lch * 8;
    const bf16* gvv = VV + (rowb + lrow) * 1024 + h * 64 + lch * 8;
    const bf16* gkr = KRB + (rowb + rrow) * RD + rch * 8;
    const unsigned wK = lrow * KP + lch * 16, wV = OFF_V + lrow * VP + lch * 16, wR = rrow * KP + 128 + rch * 16;
    const int NT = 4 * qb + 4;
    const int q4 = (lane & 15) >> 2, p4 = lane & 3, blk = (lane >> 4) & 1;
    const unsigned vlane = (4 * hi + q4) * VP + (16 * blk + 4 * p4) * 2, klane = r32 * KP + hi * 16;
    const int qrel = wid * 32 + r32;
#define PA_QK(Kb, s0, s1) do { _Pragma("unroll") for (int r_ = 0; r_ < 16; ++r_) { s0[r_] = 0.f; s1[r_] = 0.f; } \
        _Pragma("unroll") for (int d0 = 0; d0 < 6; ++d0) { const bf16x8 q_ = *(const LAS bf16x8*)(Qw + d0 * 32), a0_ = *(const LAS bf16x8*)((Kb) + klane + d0 * 32), a1_ = *(const LAS bf16x8*)((Kb) + klane + 32 * KP + d0 * 32); \
            s0 = __builtin_amdgcn_mfma_f32_32x32x16_bf16(a0_, q_, s0, 0, 0, 0); s1 = __builtin_amdgcn_mfma_f32_32x32x16_bf16(a1_, q_, s1, 0, 0, 0); } } while (0)
#define PA_SOFTMAX(jt, s0, s1) do { \
        if ((jt) >= 4 * qb) { const int kb_ = 64 * ((jt) - 4 * qb) + 4 * hi; \
            _Pragma("unroll") for (int r_ = 0; r_ < 16; ++r_) { const int kv_ = kb_ + (r_ & 3) + 8 * (r_ >> 2); if (kv_ > qrel) s0[r_] = -INFINITY; if (kv_ + 32 > qrel) s1[r_] = -INFINITY; } } \
        float rm_ = fmaxf(s0[0], s1[0]); \
        _Pragma("unroll") for (int r_ = 1; r_ < 16; ++r_) rm_ = fmaxf(rm_, fmaxf(s0[r_], s1[r_])); \
        rm_ = hmax32(rm_) * SC2; \
        if (__any(rm_ > m)) { const float mn_ = fmaxf(m, rm_), al_ = EXP2(m - mn_); m = mn_; l *= al_; \
            _Pragma("unroll") for (int r_ = 0; r_ < 16; ++r_) { o0[r_] *= al_; o1[r_] *= al_; } } \
        float ps_ = 0.f; \
        _Pragma("unroll") for (int r_ = 0; r_ < 16; ++r_) { s0[r_] = EXP2(__builtin_fmaf(s0[r_], SC2, -m)); s1[r_] = EXP2(__builtin_fmaf(s1[r_], SC2, -m)); ps_ += s0[r_] + s1[r_]; } \
        l += ps_; \
        pf[0] = pack8(s0[0], s0[1], s0[2], s0[3], s0[4], s0[5], s0[6], s0[7]); pf[1] = pack8(s0[8], s0[9], s0[10], s0[11], s0[12], s0[13], s0[14], s0[15]); \
        pf[2] = pack8(s1[0], s1[1], s1[2], s1[3], s1[4], s1[5], s1[6], s1[7]); pf[3] = pack8(s1[8], s1[9], s1[10], s1[11], s1[12], s1[13], s1[14], s1[15]); } while (0)
#define PA_PV(Vb) do { _Pragma("unroll") for (int s_ = 0; s_ < 4; ++s_) { \
            { const bf16x8 vf_ = cat8(trrd((Vb) + vlane + (16 * s_) * VP), trrd((Vb) + vlane + (16 * s_ + 8) * VP)); o0 = __builtin_amdgcn_mfma_f32_32x32x16_bf16(vf_, pf[s_], o0, 0, 0, 0); } \
            { const bf16x8 vf_ = cat8(trrd((Vb) + vlane + (16 * s_) * VP + 64), trrd((Vb) + vlane + (16 * s_ + 8) * VP + 64)); o1 = __builtin_amdgcn_mfma_f32_32x32x16_bf16(vf_, pf[s_], o1, 0, 0, 0); } } } while (0)
#ifdef PROBE_PRO_QK2
#define PA_PROBE(Kb) do { f32x16 t0_, t1_; unsigned z_ = 0; asm volatile("" : "+v"(z_)); PA_QK((Kb) + z_, t0_, t1_); _Pragma("unroll") for (int r_ = 0; r_ < 16; ++r_) { sA0[r_] += (t0_[r_] - t0_[r_]); sA1[r_] += (t1_[r_] - t1_[r_]); } } while (0)
#elif defined(PROBE_PRO_SM2)
#define PA_PROBE(Kb) do { float x_ = 0.f; asm volatile("" : "+v"(x_)); _Pragma("unroll") for (int r_ = 0; r_ < 16; ++r_) { x_ += EXP2(__builtin_fmaf(sA0[r_], SC2, x_)) + EXP2(__builtin_fmaf(sA1[r_], SC2, -x_)); } l += (x_ - x_); } while (0)
#else
#define PA_PROBE(Kb) do {} while (0)
#endif
    float m = -INFINITY, l = 0.f; f32x16 o0, o1, sA0, sA1, sB0, sB1; bf16x8 pf[4], pfp[4];
#pragma unroll
    for (int r = 0; r < 16; ++r) { o0[r] = 0.f; o1[r] = 0.f; }
    v4u rkA, rvA, rrA;
#define PA_LOAD(rk_, rv_, rr_, kt, vt) do { if ((kt) < NT) { const size_t adv_ = (size_t)(kt) * 64; rk_ = *(const v4u*)(gkn + adv_ * 1024); if (hasr) rr_ = *(const v4u*)(gkr + adv_ * RD); } \
        if ((vt) < NT) { const size_t adv_ = (size_t)(vt) * 64; rv_ = *(const v4u*)(gvv + adv_ * 1024); } } while (0)
#define PA_STORE(rk_, rv_, rr_, kt, vt) do { if ((kt) < NT) { *(LAS v4u*)(lds + ((kt) & 1) * KBUF + wK) = rk_; if (hasr) *(LAS v4u*)(lds + ((kt) & 1) * KBUF + wR) = rr_; } \
        if ((vt) < NT) *(LAS v4u*)(lds + ((vt) & 1) * VBUF + wV) = rv_; } while (0)
#define PA_SM2(jt, MASKM, s0, s1, al_, resc_) do { \
        if ((MASKM) == 1 || ((MASKM) == 2 && (jt) >= 4 * qb)) { const int kb_ = 64 * ((jt) - 4 * qb) + 4 * hi; \
            _Pragma("unroll") for (int r_ = 0; r_ < 16; ++r_) { const int kv_ = kb_ + (r_ & 3) + 8 * (r_ >> 2); if (kv_ > qrel) s0[r_] = -INFINITY; if (kv_ + 32 > qrel) s1[r_] = -INFINITY; } } \
        float rm_ = max3f(s0[0], s1[0], s0[1]), rn_ = max3f(s1[1], s0[2], s1[2]); \
        _Pragma("unroll") for (int r_ = 3; r_ < 15; r_ += 2) { rm_ = max3f(rm_, s0[r_], s1[r_]); rn_ = max3f(rn_, s0[r_ + 1], s1[r_ + 1]); } \
        rm_ = max3f(rm_, rn_, s0[15]); rm_ = fmaxf(rm_, s1[15]); \
        rm_ = hmax32(rm_) * SC2; \
        resc_ = __any(rm_ > m); al_ = 1.f; \
        if (resc_) { const float mn_ = fmaxf(m, rm_); al_ = EXP2(m - mn_); m = mn_; l *= al_; } \
        float ps_ = 0.f; \
        _Pragma("unroll") for (int r_ = 0; r_ < 16; ++r_) { s0[r_] = EXP2(__builtin_fmaf(s0[r_], SC2, -m)); s1[r_] = EXP2(__builtin_fmaf(s1[r_], SC2, -m)); ps_ += s0[r_] + s1[r_]; } \
        l += ps_; \
        pf[0] = pack8(s0[0], s0[1], s0[2], s0[3], s0[4], s0[5], s0[6], s0[7]); pf[1] = pack8(s0[8], s0[9], s0[10], s0[11], s0[12], s0[13], s0[14], s0[15]); \
        pf[2] = pack8(s1[0], s1[1], s1[2], s1[3], s1[4], s1[5], s1[6], s1[7]); pf[3] = pack8(s1[8], s1[9], s1[10], s1[11], s1[12], s1[13], s1[14], s1[15]); } while (0)
#define PA_PV2(Vb) do { _Pragma("unroll") for (int s_ = 0; s_ < 4; ++s_) { \
            { const bf16x8 vf_ = cat8(trrd((Vb) + vlane + (16 * s_) * VP), trrd((Vb) + vlane + (16 * s_ + 8) * VP)); o0 = __builtin_amdgcn_mfma_f32_32x32x16_bf16(vf_, pfp[s_], o0, 0, 0, 0); } \
            { const bf16x8 vf_ = cat8(trrd((Vb) + vlane + (16 * s_) * VP + 64), trrd((Vb) + vlane + (16 * s_ + 8) * VP + 64)); o1 = __builtin_amdgcn_mfma_f32_32x32x16_bf16(vf_, pfp[s_], o1, 0, 0, 0); } } } while (0)
#define PA_IT(t_, DOQK, DOSM, DOPV, rkS, rvS, rrS, rkL, rvL, rrL) do { const int tt_ = (t_); float al_ = 1.f; bool resc_ = false; \
        PA_LOAD(rkS, rvS, rrS, tt_ + 2, tt_); \
        if (DOQK) { LAS unsigned char* Kn_ = lds + ((tt_ + 1) & 1) * KBUF; PA_QK(Kn_, sB0, sB1); } \
        if ((DOSM) != 0) PA_SM2(tt_, (DOSM) - 1, sA0, sA1, al_, resc_); \
        __builtin_amdgcn_sched_barrier(0); \
        if (DOPV) { LAS unsigned char* Vb_ = lds + OFF_V + ((tt_ - 1) & 1) * VBUF; PA_PV2(Vb_); } \
        if ((DOSM) != 0 && resc_) { _Pragma("unroll") for (int r_ = 0; r_ < 16; ++r_) { o0[r_] *= al_; o1[r_] *= al_; } } \
        if ((DOSM) != 0) { pfp[0] = pf[0]; pfp[1] = pf[1]; pfp[2] = pf[2]; pfp[3] = pf[3]; } \
        if (DOQK) { sA0 = sB0; sA1 = sB1; } \
        PA_STORE(rkS, rvS, rrS, tt_ + 2, tt_); \
        __syncthreads(); } while (0)
    { const v4u rk = *(const v4u*)gkn, rk1 = *(const v4u*)(gkn + (size_t)64 * 1024); v4u rr = (v4u){0u, 0u, 0u, 0u}, rr1 = rr; if (hasr) { rr = *(const v4u*)gkr; rr1 = *(const v4u*)(gkr + (size_t)64 * RD); }
      *(LAS v4u*)(lds + wK) = rk; if (hasr) *(LAS v4u*)(lds + wR) = rr;
      *(LAS v4u*)(lds + KBUF + wK) = rk1; if (hasr) *(LAS v4u*)(lds + KBUF + wR) = rr1; }
    __syncthreads();
    PA_QK(lds, sA0, sA1);
    __syncthreads();
    PA_IT(0, true, 3, false, rkA, rvA, rrA, rkA, rvA, rrA);
    if (qb > 0) {
#pragma unroll 1
        for (int t = 1; t < NT - 5; t += 2) {
            PA_IT(t, true, 1, true, rkA, rvA, rrA, rkA, rvA, rrA);
            PA_IT(t + 1, true, 1, true, rkA, rvA, rrA, rkA, rvA, rrA);
        }
        PA_IT(NT - 5, true, 1, true, rkA, rvA, rrA, rkA, rvA, rrA);
        PA_IT(NT - 4, true, 2, true, rkA, rvA, rrA, rkA, rvA, rrA);
    }
    PA_IT(NT - 3, true, 2, true, rkA, rvA, rrA, rkA, rvA, rrA);
    PA_IT(NT - 2, true, 2, true, rkA, rvA, rrA, rkA, rvA, rrA);
    PA_IT(NT - 1, false, 2, true, rkA, rvA, rrA, rkA, rvA, rrA);
    PA_IT(NT, false, 0, true, rkA, rvA, rrA, rkA, rvA, rrA);
#undef PA_LOAD
#undef PA_STORE
#undef PA_SM2
#undef PA_PV2
#undef PA_IT
#undef PA_QK
#undef PA_SOFTMAX
#undef PA_PV
    l += __shfl_xor(l, 32); const float inv = 1.f / l;
    bf16* op = O + (rowb + qw + r32) * 1024 + h * 64 + 4 * hi;
#pragma unroll
    for (int g4 = 0; g4 < 4; ++g4) { v2u w; w.x = cvtpk(o0[4 * g4] * inv, o0[4 * g4 + 1] * inv); w.y = cvtpk(o0[4 * g4 + 2] * inv, o0[4 * g4 + 3] * inv); *(v2u*)(op + 8 * g4) = w;
        w.x = cvtpk(o1[4 * g4] * inv, o1[4 * g4 + 1] * inv); w.y = cvtpk(o1[4 * g4 + 2] * inv, o1[4 * g4 + 3] * inv); *(v2u*)(op + 32 + 8 * g4) = w; }
}

template <bool NEWK>
__device__ __forceinline__ void dattn_step(LAS unsigned char* Kb, LAS unsigned char* Qw, f32x16 (&o)[8], float& m, float& l, unsigned klane, unsigned vlane, int hi, int stok) {
    constexpr int KP = 592;
    f32x16 p0, p1;
#pragma unroll
    for (int r = 0; r < 16; ++r) { p0[r] = 0.f; p1[r] = 0.f; }
    { bf16x8 fq[2][2], fa[2][2], fb[2][2];
#define DS_LD(set, g_) do { _Pragma("unroll") for (int e_ = 0; e_ < 2; ++e_) { const int ks_ = 2 * (g_) + e_; fq[set][e_] = *(const LAS bf16x8*)(Qw + klane + ks_ * 32); fa[set][e_] = *(const LAS bf16x8*)(Kb + klane + ks_ * 32); \
            if (!NEWK) fb[set][e_] = *(const LAS bf16x8*)(Kb + klane + 32 * KP + ks_ * 32); } } while (0)
#define DS_MM(set) do { _Pragma("unroll") for (int e_ = 0; e_ < 2; ++e_) { p0 = __builtin_amdgcn_mfma_f32_32x32x16_bf16(fa[set][e_], fq[set][e_], p0, 0, 0, 0); \
            if (!NEWK) p1 = __builtin_amdgcn_mfma_f32_32x32x16_bf16(fb[set][e_], fq[set][e_], p1, 0, 0, 0); } } while (0)
      DS_LD(0, 0);
#pragma unroll
      for (int g2 = 0; g2 < 9; g2 += 2) {
          if (g2 + 1 < 9) DS_LD(1, g2 + 1);
          __builtin_amdgcn_sched_barrier(0); DS_MM(0); __builtin_amdgcn_sched_barrier(0);
          if (g2 + 2 < 9) DS_LD(0, g2 + 2);
          __builtin_amdgcn_sched_barrier(0); if (g2 + 1 < 9) DS_MM(1); __builtin_amdgcn_sched_barrier(0);
      }
#undef DS_LD
#undef DS_MM
    }
    if (NEWK) {
#pragma unroll
        for (int r = 0; r < 16; ++r) { const int key = (r & 3) + 8 * (r >> 2) + 4 * hi; if (key > stok) p0[r] = -INFINITY; p1[r] = -INFINITY; } }
    float rm = fmaxf(p0[0], p1[0]);
#pragma unroll
    for (int r = 1; r < 16; ++r) rm = fmaxf(rm, fmaxf(p0[r], p1[r]));
    rm = hmax32(rm) * SC2;
    if (__any(rm > m)) { const float mn = fmaxf(m, rm), al = EXP2(m - mn); m = mn; l *= al;
#pragma unroll
        for (int c = 0; c < 8; ++c)
#pragma unroll
            for (int r = 0; r < 16; ++r) o[c][r] *= al; }
    float ps = 0.f;
#pragma unroll
    for (int r = 0; r < 16; ++r) { p0[r] = EXP2(__builtin_fmaf(p0[r], SC2, -m)); p1[r] = EXP2(__builtin_fmaf(p1[r], SC2, -m)); ps += p0[r] + p1[r]; }
    l += ps;
    bf16x8 pf[4];
    pf[0] = pack8(p0[0], p0[1], p0[2], p0[3], p0[4], p0[5], p0[6], p0[7]); pf[1] = pack8(p0[8], p0[9], p0[10], p0[11], p0[12], p0[13], p0[14], p0[15]);
    pf[2] = pack8(p1[0], p1[1], p1[2], p1[3], p1[4], p1[5], p1[6], p1[7]); pf[3] = pack8(p1[8], p1[9], p1[10], p1[11], p1[12], p1[13], p1[14], p1[15]);
    { constexpr int NG = NEWK ? 2 : 8; s16x4 vl[2][4], vh[2][4];
#define DV_LD(set, g_) do { const int s_ = (g_) >> 1, c0_ = 4 * ((g_) & 1); _Pragma("unroll") for (int e_ = 0; e_ < 4; ++e_) { \
            vl[set][e_] = trrd(Kb + vlane + (16 * s_) * KP + (c0_ + e_) * 64); vh[set][e_] = trrd(Kb + vlane + (16 * s_ + 8) * KP + (c0_ + e_) * 64); } } while (0)
#define DV_MM(set, g_) do { const int s_ = (g_) >> 1, c0_ = 4 * ((g_) & 1); _Pragma("unroll") for (int e_ = 0; e_ < 4; ++e_) \
            o[c0_ + e_] = __builtin_amdgcn_mfma_f32_32x32x16_bf16(cat8(vl[set][e_], vh[set][e_]), pf[s_], o[c0_ + e_], 0, 0, 0); } while (0)
      DV_LD(0, 0);
#pragma unroll
      for (int g2 = 0; g2 < NG; g2 += 2) {
          DV_LD(1, g2 + 1);
          __builtin_amdgcn_sched_barrier(0); DV_MM(0, g2); __builtin_amdgcn_sched_barrier(0);
          if (g2 + 2 < NG) DV_LD(0, g2 + 2);
          __builtin_amdgcn_sched_barrier(0); DV_MM(1, g2 + 1); __builtin_amdgcn_sched_barrier(0);
      }
#undef DV_LD
#undef DV_MM
    }
}
__device__ __forceinline__ void dattn_unit(LAS unsigned char* lds, const bf16* QD, const float* ckvc, const float* krc, const int* ptab, const bf16* CKV, const bf16* KRB, float* DPART, float* DML, int unit) {
    const int bd = unit >> 1, half = unit & 1;
    const int tid = opaque_tid(), lane = tid & 63, wid = __builtin_amdgcn_readfirstlane(tid >> 6), r32 = lane & 31, hi = lane >> 5;
    constexpr int KP = 592, KBUF = 64 * KP;
    const bool comp = wid < 4;
    for (int i = tid; i < 128 * 36; i += NWAVES * 64) { const int row = i / 36, ch = i % 36; *(LAS v4u*)(lds + 2 * KBUF + row * KP + ch * 16) = *(const v4u*)(QD + ((size_t)bd * 128 + row) * 288 + ch * 8); }
    const int* pt = ptab + bd * NPAGE;
    const int lt = tid & 255;
    f32x4 preA[18], preB[18];
#define DLOAD(pre, T) do { const int T_ = (T); const size_t rb_ = (size_t)pt[T_ >> 1] * 128 + (size_t)(T_ & 1) * 64; const float* lp_ = ckvc + rb_ * 256; const float* rp_ = krc + rb_ * 32; \
        _Pragma("unroll") for (int i_ = 0; i_ < 16; ++i_) pre[i_] = __builtin_nontemporal_load((const f32x4*)(lp_ + (size_t)(lt + 256 * i_) * 4)); \
        _Pragma("unroll") for (int i_ = 0; i_ < 2; ++i_) pre[16 + i_] = __builtin_nontemporal_load((const f32x4*)(rp_ + (size_t)(lt + 256 * i_) * 4)); } while (0)
#define DSTORE(pre, buf) do { LAS unsigned char* b_ = lds + (buf) * KBUF; \
        _Pragma("unroll") for (int i_ = 0; i_ < 16; ++i_) { const int id_ = lt + 256 * i_; v2u w_; w_.x = cvtpk(pre[i_].x, pre[i_].y); w_.y = cvtpk(pre[i_].z, pre[i_].w); *(LAS v2u*)(b_ + (id_ >> 6) * KP + (id_ & 63) * 8) = w_; } \
        _Pragma("unroll") for (int i_ = 0; i_ < 2; ++i_) { const int id_ = lt + 256 * i_; v2u w_; w_.x = cvtpk(pre[16 + i_].x, pre[16 + i_].y); w_.y = cvtpk(pre[16 + i_].z, pre[16 + i_].w); *(LAS v2u*)(b_ + (id_ >> 3) * KP + 512 + (id_ & 7) * 8) = w_; } } while (0)
    const int T0 = half * 64;
    float m = -INFINITY, l = 0.f; f32x16 o[8];
    const int q4 = (lane & 15) >> 2, p4 = lane & 3, blk = (lane >> 4) & 1;
    const unsigned klane = r32 * KP + hi * 16, vlane = (4 * hi + q4) * KP + (16 * blk + 4 * p4) * 2;
    LAS unsigned char* Qw = lds + 2 * KBUF + (wid & 3) * 32 * KP;
    const int stok = 2 * (wid & 3) + (r32 >> 4);
    if (comp) {
#pragma unroll
        for (int c = 0; c < 8; ++c)
#pragma unroll
            for (int r = 0; r < 16; ++r) o[c][r] = 0.f;
        __syncthreads();
#pragma unroll 1
        for (int j = 0; j < 64; j += 2) {
            dattn_step<false>(lds, Qw, o, m, l, klane, vlane, hi, stok);
            __syncthreads();
            dattn_step<false>(lds + KBUF, Qw, o, m, l, klane, vlane, hi, stok);
            __syncthreads();
        }
    } else {
        DLOAD(preA, T0); DLOAD(preB, T0 + 1); DSTORE(preA, 0); DLOAD(preA, T0 + 2);
        __syncthreads();
#pragma unroll 1
        for (int j = 0; j < 64; j += 2) {
            DSTORE(preB, 1); DLOAD(preB, T0 + (j + 3 < 64 ? j + 3 : 63));
            __syncthreads();
            DSTORE(preA, 0); DLOAD(preA, T0 + (j + 4 < 64 ? j + 4 : 63));
            __syncthreads();
        }
    }
#undef DLOAD
#undef DSTORE
    if (half == 1) {
        for (int i = tid; i < 32 * 36; i += NWAVES * 64) { const int row = i / 36, ch = i % 36; v4u v = (v4u){0u, 0u, 0u, 0u};
            if (row < 8) v = ch < 32 ? *(const v4u*)(CKV + (size_t)(NPR + bd * 8 + row) * KVL + ch * 8) : *(const v4u*)(KRB + (size_t)(NPR + bd * 8 + row) * RD + (ch - 32) * 8);
            *(LAS v4u*)(lds + row * KP + ch * 16) = v; }
        __syncthreads();
        if (comp) dattn_step<true>(lds, Qw, o, m, l, klane, vlane, hi, stok);
        __syncthreads();
    }
    if (comp) {
        l += __shfl_xor(l, 32);
        const int row = (wid & 3) * 32 + r32;
        float* dp = DPART + ((size_t)unit * 128 + row) * 256 + 4 * hi;
#pragma unroll
        for (int c = 0; c < 8; ++c)
#pragma unroll
            for (int g4 = 0; g4 < 4; ++g4) *(f32x4*)(dp + 32 * c + 8 * g4) = (f32x4){o[c][4 * g4], o[c][4 * g4 + 1], o[c][4 * g4 + 2], o[c][4 * g4 + 3]};
        if (hi == 0) { DML[((size_t)unit * 128 + row) * 2] = m; DML[((size_t)unit * 128 + row) * 2 + 1] = l; }
    }
}

__device__ __forceinline__ void ph_attention(const Frame& F, const Args& a) {
    unsigned char* ws = a.ws;
    const bf16* QP = (const bf16*)(ws + WS_QP); const bf16* KN = (const bf16*)(ws + WS_KN); const bf16* KRB = (const bf16*)(ws + WS_KRB); const bf16* VV = (const bf16*)(ws + WS_VV); bf16* O = (bf16*)(ws + WS_O);
#ifndef PROBE_DEC_REP
#define PROBE_DEC_REP 1
#endif
#ifndef PROBE_PRO_REP
#define PROBE_PRO_REP 1
#endif
#ifndef ATT_ORDER
#define ATT_ORDER 2
#endif
#define DEC_UNITS() do { _Pragma("unroll 1") for (int rep_ = 0; rep_ < PROBE_DEC_REP; ++rep_) _Pragma("unroll 1") for (int u = F.vcu; u < 2 * NDB; u += F.G) \
        dattn_unit(F.lds, (const bf16*)(ws + WS_QD), (const float*)a.in[2], (const float*)a.in[3], (const int*)a.in[6], (const bf16*)(ws + WS_CKV), KRB, (float*)(ws + WS_DPART), (float*)(ws + WS_DML), u); } while (0)
#define PRO_UNITS(i0_, i1_) do { _Pragma("unroll 1") for (int rep_ = 0; rep_ < PROBE_PRO_REP; ++rep_) { \
        if (F.G == 256) { const int xq = F.vcu >> 5, jq = F.vcu & 31; \
            _Pragma("unroll 1") for (int i = (i0_); i < (i1_); ++i) { const int bh = 4 * xq + i, qb = (i & 1) ? 31 - jq : jq; pattn_unit(F.lds, QP, KN, KRB, VV, O, bh >> 4, bh & 15, qb); } \
        } else if ((i0_) == 0) { _Pragma("unroll 1") for (int u = F.vcu; u < 1024; u += F.G) pattn_unit(F.lds, QP, KN, KRB, VV, O, u >> 9, (u >> 5) & 15, 31 - (u & 31)); } } } while (0)
#if ATT_ORDER == 3
    const int dpos = F.vcu % 5;
    if (F.G == 256) { const int xq = F.vcu >> 5, jq = F.vcu & 31;
#pragma unroll 1
        for (int i = 0; i < 4; ++i) { if (i == dpos) DEC_UNITS();
            const int bh = 4 * xq + i, qb = (i & 1) ? 31 - jq : jq; pattn_unit(F.lds, QP, KN, KRB, VV, O, bh >> 4, bh & 15, qb); }
        if (dpos == 4) DEC_UNITS();
    } else { DEC_UNITS(); PRO_UNITS(0, 4); }
#elif ATT_ORDER == 2
    const int dpos = F.vcu % 3;
    if (dpos == 0) DEC_UNITS();
    if (F.G == 256) { const int xq = F.vcu >> 5, jq = F.vcu & 31;
#pragma unroll 1
        for (int i = 0; i < 4; ++i) { if (i == 2 && dpos == 1) DEC_UNITS();
            const int bh = 4 * xq + i, qb = (i & 1) ? 31 - jq : jq; pattn_unit(F.lds, QP, KN, KRB, VV, O, bh >> 4, bh & 15, qb); }
    } else { if (dpos == 1) DEC_UNITS(); PRO_UNITS(0, 4); }
    if (dpos == 2) DEC_UNITS();
#else
    const bool dec_first = ATT_ORDER ? (F.vcu & 1) : true;
    if (dec_first) DEC_UNITS();
    PRO_UNITS(0, 4);
    if (!dec_first) DEC_UNITS();
#endif
#undef DEC_UNITS
#undef PRO_UNITS
}

__device__ __forceinline__ void ph_dcombine(const Frame& F, const Args& a) {
    unsigned char* ws = a.ws;
    const float* DPART = (const float*)(ws + WS_DPART); const float* DML = (const float*)(ws + WS_DML); const float* wuv = (const float*)a.in[21]; bf16* O = (bf16*)(ws + WS_O);
    LAS float* olat = (LAS float*)F.lds;
    const int lane = F.lane, w = F.wave;
    for (int un = F.vcu; un < 2 * NDB; un += F.G) { const int bd = un >> 1, hh = un & 1;
#pragma unroll 4
        for (int h8 = 0; h8 < 8; ++h8) { const int r = w * 16 + 8 * hh + h8;
            const size_t u0 = (size_t)(bd * 2) * 128 + r, u1 = (size_t)(bd * 2 + 1) * 128 + r;
            const f32x2 ml0 = *(const f32x2*)(DML + u0 * 2), ml1 = *(const f32x2*)(DML + u1 * 2);
            const float M = fmaxf(ml0.x, ml1.x), w0 = EXP2(ml0.x - M), w1 = EXP2(ml1.x - M), L = ml0.y * w0 + ml1.y * w1;
            const f32x4 acc = *(const f32x4*)(DPART + u0 * 256 + 4 * lane) * w0 + *(const f32x4*)(DPART + u1 * 256 + 4 * lane) * w1;
            *(LAS f32x4*)(olat + (h8 * 8 + w) * 256 + ((4 * lane) ^ (4 * (h8 & 3)))) = acc * (1.f / L);
        }
        __syncthreads();
        { const int qd = w & 1, kq = w >> 1, hl = lane >> 4, h8 = 4 * qd + hl, h = 8 * hh + h8, v0 = 4 * (lane & 15), sw = 4 * hl;
          f32x4 acc[8];
#pragma unroll
          for (int s = 0; s < 8; ++s) acc[s] = (f32x4){0.f, 0.f, 0.f, 0.f};
          const float* wp = wuv + (size_t)(64 * kq) * 1024 + 256 * (2 * hh + qd) + 4 * lane; const LAS float* ob = olat + (h8 * 8) * 256;
#pragma unroll 4
          for (int kk = 0; kk < 16; ++kk) { const int k = 64 * kq + 4 * kk;
              const f32x4 w0 = *(const f32x4*)(wp + (size_t)(4 * kk) * 1024), w1 = *(const f32x4*)(wp + (size_t)(4 * kk + 1) * 1024), w2 = *(const f32x4*)(wp + (size_t)(4 * kk + 2) * 1024), w3 = *(const f32x4*)(wp + (size_t)(4 * kk + 3) * 1024);
#pragma unroll
              for (int s = 0; s < 8; ++s) { const f32x4 o = *(const LAS f32x4*)(ob + s * 256 + (k ^ sw)); acc[s] = acc[s] + w0 * o.x + w1 * o.y + w2 * o.z + w3 * o.w; } }
          __syncthreads();
          if (kq > 0) { LAS f32x4* xs = (LAS f32x4*)F.lds + (((kq - 1) * 2 + qd) * 64 + lane) * 8;
#pragma unroll
              for (int s = 0; s < 8; ++s) xs[s] = acc[s]; }
          __syncthreads();
          if (kq == 0) {
#pragma unroll
              for (int s = 0; s < 8; ++s) { f32x4 t = acc[s];
#pragma unroll
                  for (int q = 0; q < 3; ++q) t = t + ((const LAS f32x4*)F.lds)[((q * 2 + qd) * 64 + lane) * 8 + s];
                  v2u o; o.x = pk2(t.x, t.y); o.y = pk2(t.z, t.w); *(v2u*)(O + (size_t)(NPR + bd * 8 + s) * 1024 + h * 64 + v0) = o; } }
          __syncthreads();
        }
    }
}

__device__ __forceinline__ void ph_conv(const Frame& F, const Args& a, int L) {
    unsigned char* ws = a.ws; const bf16* U = (const bf16*)(ws + WS_U); bf16* A2 = (bf16*)(ws + WS_A2);
    const float* cw = (const float*)a.in[26] + (size_t)L * 3 * FF2; const float* cb = (const float*)a.in[27] + (size_t)L * FF2; const float* stc = (const float*)a.in[5] + (size_t)L * NDB * 2 * FF2;
    const int tid = F.tid;
    if (tid >= 352) return;
    const int c = 8 * tid, NI = NR / 8;
    f32x4 wgt[2][4][2];
#pragma unroll
    for (int p = 0; p < 2; ++p)
#pragma unroll
        for (int k = 0; k < 4; ++k) { const float* src = (k < 3 ? cw + (size_t)k * FF2 : cb) + p * FF + c; wgt[p][k][0] = *(const f32x4*)src; wgt[p][k][1] = *(const f32x4*)(src + 4); }
    const int ilast = F.vcu + ((NI - 1 - F.vcu) / F.G) * F.G;
#define CV_ROWPTR(item_, p_, i_) (U + (size_t)(((item_) < ilast ? (item_) : ilast) * 8 + (((i_) < 2 && ((((item_) < ilast ? (item_) : ilast) * 8 >= NPR) || (((((item_) < ilast ? (item_) : ilast) * 8) & 8191) == 0))) ? 0 : (i_) - 2)) * FF2 + (p_) * FF + c)
#define CV_UNPACK(dst, v) do { dst[0] = bflo((v).x); dst[1] = bfhi((v).x); dst[2] = bflo((v).y); dst[3] = bfhi((v).y); dst[4] = bflo((v).z); dst[5] = bfhi((v).z); dst[6] = bflo((v).w); dst[7] = bfhi((v).w); } while (0)
    v4u raw[2][10];
#pragma unroll
    for (int i = 0; i < 2; ++i)
#pragma unroll
        for (int p = 0; p < 2; ++p) raw[p][i] = *(const v4u*)CV_ROWPTR(F.vcu, p, i);
#pragma unroll
    for (int i = 2; i < 10; ++i)
#pragma unroll
        for (int p = 0; p < 2; ++p) raw[p][i] = *(const v4u*)CV_ROWPTR(F.vcu, p, i);
#pragma unroll 1
    for (int item = F.vcu; item < NI; item += F.G) {
        const int nxt = item + F.G;
        const int row0 = item * 8; const bool smp = row0 >= NPR; const int bd = (row0 - NPR) >> 3, t0 = row0 & 8191;
        float um2[2][8], um1[2][8];
#pragma unroll
        for (int i = 0; i < 2; ++i)
#pragma unroll
            for (int p = 0; p < 2; ++p) { if (i == 0) CV_UNPACK(um2[p], raw[p][0]); else CV_UNPACK(um1[p], raw[p][1]); raw[p][i] = *(const v4u*)CV_ROWPTR(nxt, p, i); }
#pragma unroll
        for (int p = 0; p < 2; ++p) {
            if (smp) { const float* s0 = stc + ((size_t)bd * 2) * FF2 + p * FF + c;
#pragma unroll
                for (int e = 0; e < 8; ++e) { um2[p][e] = s0[e]; um1[p][e] = s0[FF2 + e]; } }
            else if (t0 == 0) {
#pragma unroll
                for (int e = 0; e < 8; ++e) { um2[p][e] = 0.f; um1[p][e] = 0.f; } } }
#pragma unroll
        for (int t = 0; t < 8; ++t) { float cv[2][8];
#pragma unroll
            for (int p = 0; p < 2; ++p) { float u0[8]; CV_UNPACK(u0, raw[p][t + 2]); raw[p][t + 2] = *(const v4u*)CV_ROWPTR(nxt, p, t + 2);
#pragma unroll
                for (int h4 = 0; h4 < 2; ++h4) { const f32x4 k0 = wgt[p][0][h4], k1 = wgt[p][1][h4], k2 = wgt[p][2][h4], kb = wgt[p][3][h4];
#pragma unroll
                    for (int e4 = 0; e4 < 4; ++e4) { const int e = 4 * h4 + e4; cv[p][e] = kb[e4] + um2[p][e] * k0[e4] + um1[p][e] * k1[e4] + u0[e] * k2[e4]; um2[p][e] = um1[p][e]; um1[p][e] = u0[e]; } } }
            float g[8];
#pragma unroll
            for (int e = 0; e < 8; ++e) { const float x = cv[0][e]; g[e] = x * __builtin_amdgcn_rcpf(1.f + __builtin_amdgcn_exp2f(x * -1.4426950408889634f)) * cv[1][e]; }
            v4u o; o.x = cvtpk(g[0], g[1]); o.y = cvtpk(g[2], g[3]); o.z = cvtpk(g[4], g[5]); o.w = cvtpk(g[6], g[7]);
            *(v4u*)(A2 + (size_t)(row0 + t) * FF + c) = o; }
        if (smp || t0 == 8184) { float* so = smp ? a.out + OUT_CSS + ((size_t)(L * NDB + bd) * 2) * FF2 : a.out + OUT_CSP + ((size_t)(L * 2 + (row0 >> 13)) * 2) * FF2;
#pragma unroll
            for (int p = 0; p < 2; ++p)
#pragma unroll
                for (int e = 0; e < 8; ++e) { so[p * FF + c + e] = um2[p][e]; so[FF2 + p * FF + c + e] = um1[p][e]; } }
    }
#undef CV_ROWPTR
#undef CV_UNPACK
}

__device__ __forceinline__ void ph_pool(const Frame& F, const Args& a) {
    unsigned char* ws = a.ws; const bf16* H1 = (const bf16*)(ws + WS_H1); bf16* PO = (bf16*)(ws + WS_POOLED); const float* stp = (const float*)a.in[4];
    const int tid = F.tid, sub = tid >> 7, cg = tid & 127, d = 8 * cg, wdw = 2 << (cg >> 5);
#pragma unroll 1
    for (int item = 4 * F.vcu + sub; item < NR / 8; item += 4 * F.G) {
        const int row0 = item * 8; const bool smp = row0 >= NPR; const int bd = (row0 - NPR) >> 3, t0 = row0 & 8191;
        v4u r[23];
#pragma unroll
        for (int i = 0; i < 23; ++i) { const int tt = i - 15; r[i] = (v4u){0u, 0u, 0u, 0u};
            if (tt > -wdw) { if (smp && tt < 0) { const float* sp = stp + ((size_t)bd * 15 + 15 + tt) * DM + d; const f32x4 s0 = *(const f32x4*)sp, s1 = *(const f32x4*)(sp + 4);
                                 r[i].x = pk2(s0.x, s0.y); r[i].y = pk2(s0.z, s0.w); r[i].z = pk2(s1.x, s1.y); r[i].w = pk2(s1.z, s1.w); }
                             else if (smp || t0 + tt >= 0) r[i] = *(const v4u*)(H1 + (size_t)(row0 + tt) * DM + d); } }
        float sum[8];
#pragma unroll
        for (int e = 0; e < 8; ++e) sum[e] = 0.f;
#define PL_ACC(v, sgn) do { sum[0] += (sgn) * bflo((v).x); sum[1] += (sgn) * bfhi((v).x); sum[2] += (sgn) * bflo((v).y); sum[3] += (sgn) * bfhi((v).y); \
        sum[4] += (sgn) * bflo((v).z); sum[5] += (sgn) * bfhi((v).z); sum[6] += (sgn) * bflo((v).w); sum[7] += (sgn) * bfhi((v).w); } while (0)
#pragma unroll
        for (int i = 0; i < 15; ++i) if (i - 15 > -wdw) PL_ACC(r[i], 1.f);
#pragma unroll
        for (int t = 0; t < 8; ++t) { const v4u cur = r[15 + t]; PL_ACC(cur, 1.f);
            const int pc = t0 + t + 1; const float ic = 1.f / (smp ? (float)wdw : (float)(pc < wdw ? pc : wdw));
            v4u o; o.x = pk2(sum[0] * ic - bflo(cur.x), sum[1] * ic - bfhi(cur.x)); o.y = pk2(sum[2] * ic - bflo(cur.y), sum[3] * ic - bfhi(cur.y));
            o.z = pk2(sum[4] * ic - bflo(cur.z), sum[5] * ic - bfhi(cur.z)); o.w = pk2(sum[6] * ic - bflo(cur.w), sum[7] * ic - bfhi(cur.w));
            *(v4u*)(PO + (size_t)(row0 + t) * DM + d) = o;
            const v4u old = wdw == 2 ? r[14 + t] : wdw == 4 ? r[12 + t] : wdw == 8 ? r[8 + t] : r[t];
            PL_ACC(old, -1.f); }
#undef PL_ACC
    }
    const int gw = F.vcu * NWAVES + F.wave, NGW = F.G * NWAVES, lane = F.lane;
    for (int i = gw; i < NDB * 7; i += NGW) { const int bd = i / 7, k = i % 7; const float* src = stp + ((size_t)bd * 15 + 8 + k) * DM; float* dst = a.out + OUT_PSS + ((size_t)bd * 15 + k) * DM;
#pragma unroll
        for (int j = 0; j < 4; ++j) *(f32x4*)(dst + 4 * lane + 256 * j) = *(const f32x4*)(src + 4 * lane + 256 * j);
    }
}

constexpr int NPHASES = 22;
#ifndef PROBE_GEMM_REP
#define PROBE_GEMM_REP 1
#endif
#ifndef PROBE_THIN_REP
#define PROBE_THIN_REP 1
#endif
#ifndef PROBE_THIN_MASK
#define PROBE_THIN_MASK 0
#endif
#define TREPK(k) _Pragma("unroll 1") for (int rep_ = 0; rep_ < (((PROBE_THIN_MASK >> (k)) & 1) ? 2 : 1); ++rep_)
#ifndef MK_PER_PHASE
#define MK_PER_PHASE 0
#endif

#define PROJ1024(Aptr, lda_, Btptr, Ktot, S_, Optr) do { \
        pg8::Gemm gh{(const pg8::bf16_t*)(Aptr), (const pg8::bf16_t*)(Btptr), NR, 1024, (Ktot) / (S_), (lda_), 0, (Ktot)}; pg8::HybridOrder<S_> Sh; Sh.init(NPR, 1024, (Ktot), F.G, (int)blockIdx.x); \
        pg8::EpiHybrid Eh{(pg8::bf16_t*)(Optr), 1024, (float*)(ws + WS_TMPS), (size_t)NSR * 1024}; \
        pg8::gemm_phase<pg8::EpiHybrid, pg8::HybridOrder<S_>, true, true>(F.lds, gh, Sh, Eh); } while (0)

#define AS4 __attribute__((address_space(4)))
__device__ __forceinline__ Args fresh_args() {
    const Args AS4* ap = (const Args AS4*)__builtin_amdgcn_kernarg_segment_ptr();
    asm volatile("" : "+s"(ap));
    Args a;
#pragma unroll
    for (int i = 0; i < 29; ++i) a.in[i] = ap->in[i];
    a.out = ap->out; a.ws = ap->ws; a.ph_lo = ap->ph_lo; a.ph_hi = ap->ph_hi;
    return a;
}
#define PHASE_ARGS const Args args = fresh_args(); unsigned char* const ws = args.ws; float* const out = args.out; float* const MOD = (float*)(ws + WS_MOD); float* const TMP = (float*)(ws + WS_TMP); \
    bf16* const TMPb = (bf16*)(ws + WS_TMP); bf16* const HN = (bf16*)(ws + WS_HN); (void)out; (void)MOD; (void)TMP; (void)TMPb; (void)HN

__device__ __forceinline__ bool fresh(Frame& F) { const int t = opaque_tid(); F.tid = t; F.lane = t & 63; return true; }

__device__ __forceinline__ void ffn_gemms(Frame& F, int L, int pbase, int lo, int hi, const XcdBarrier& bar) {
#define IN(k) ((lo <= (k) && (k) < hi) && fresh(F))
#ifdef PROBE_BAR2
#define SEAM(k) do { if ((lo <= (k) && (k) < hi) && (lo <= (k) + 1 && (k) + 1 < hi)) { xcd_barrier(bar); xcd_barrier(bar); } } while (0)
#else
#define SEAM(k) do { if ((lo <= (k) && (k) < hi) && (lo <= (k) + 1 && (k) + 1 < hi)) xcd_barrier(bar); } while (0)
#endif
    if (IN(pbase)) { PHASE_ARGS;
        pg8::Gemm g{(const pg8::bf16_t*)(ws + WS_HN), (const pg8::bf16_t*)(ws + WS_WUP) + (size_t)L * FF2 * 1024, NR, FF2, 1024, 1024, 0, 1024}; pg8::StaticOrder S; S.init(NR, FF2, F.G, (int)blockIdx.x);
        pg8::EpiBf16<0> E{(pg8::bf16_t*)(ws + WS_U), FF2, nullptr, 0, 0, 1.f};
        pg8::gemm_phase<pg8::EpiBf16<0>, pg8::StaticOrder, true, true>(F.lds, g, S, E);
#ifdef PROBE_UP2
        pg8::gemm_phase<pg8::EpiBf16<0>, pg8::StaticOrder, true, true>(F.lds, g, S, E);
#endif
    }
    SEAM(pbase);
    if (IN(pbase + 1)) { PHASE_ARGS; TREPK(5) ph_conv(F, args, L); }
    SEAM(pbase + 1);
    if (IN(pbase + 2)) { PHASE_ARGS;
        PROJ1024(ws + WS_A2, FF, (const pg8::bf16_t*)(ws + WS_WDOWN) + (size_t)L * 1024 * FF, FF, 11, ws + WS_TMP);
    }
    SEAM(pbase + 2);
#undef IN
#undef SEAM
}

__global__ void __launch_bounds__(NWAVES * 64, 2) fwd(Args args_in_kernarg) {
    extern __shared__ __attribute__((aligned(16))) unsigned char lds[];
    Frame F;
    F.lds = (LAS unsigned char*)lds; F.MISC = (volatile LAS unsigned*)(F.lds + MISC_OFF);
    F.tid = threadIdx.x; F.lane = F.tid & 63; F.wave = __builtin_amdgcn_readfirstlane(F.tid >> 6);
    F.G = gridDim.x; { const int bx = blockIdx.x; F.vcu = (F.G % 8 == 0) ? (bx % 8) * (F.G / 8) + bx / 8 : bx; }
    int lo, hi; { const Args a0 = fresh_args(); F.ctl = (gu32*)(a0.ws + WS_CTL); lo = a0.ph_lo; hi = a0.ph_hi; }
    for (int u = F.tid; u < (LDS_BYTES - LDSCTL_OFF) / 4; u += NWAVES * 64) ((LAS unsigned*)(F.lds + LDSCTL_OFF))[u] = 0u;
    __syncthreads();
    XcdBarrier bar; bar.bar = (unsigned*)(F.ctl + CW_BAR); bar.x = 0; bar.st = nullptr;
    if (hi - lo > 1) bar = xcd_barrier_post((unsigned*)(F.ctl + CW_BAR), F.MISC + 8);
#define IN(k) ((lo <= (k) && (k) < hi) && fresh(F))
#ifdef PROBE_BAR2
#define SEAM(k) do { if ((lo <= (k) && (k) < hi) && (lo <= (k) + 1 && (k) + 1 < hi)) { xcd_barrier(bar); xcd_barrier(bar); } } while (0)
#else
#define SEAM(k) do { if ((lo <= (k) && (k) < hi) && (lo <= (k) + 1 && (k) + 1 < hi)) xcd_barrier(bar); } while (0)
#endif

    const bool defer = F.G >= 96;
    if (IN(0)) { PHASE_ARGS; ph_prologue<0>(F, args, F.vcu * NWAVES + F.wave, F.G * NWAVES); if (!defer) ph_prologue<1>(F, args, F.vcu * NWAVES + F.wave, F.G * NWAVES); }
    SEAM(0);
    if (IN(1)) { PHASE_ARGS;
        pg8::Gemm g{(const pg8::bf16_t*)(ws + WS_SILUC), (const pg8::bf16_t*)(ws + WS_ADAT), 256, 12288, 1024, 1024, 0, 1024}; pg8::StaticOrder S; S.init(256, 12288, F.G, (int)blockIdx.x);
        pg8::EpiF32 E{MOD, 12288, (const float*)args.in[10], nullptr, 0};
        pg8::gemm_phase<pg8::EpiF32, pg8::StaticOrder, true, true>(F.lds, g, S, E);
        if (defer && (int)blockIdx.x >= 48) ph_prologue<1>(F, args, ((int)blockIdx.x - 48) * NWAVES + F.wave, (F.G - 48) * NWAVES);
    }
    SEAM(1);
    if (IN(2)) { PHASE_ARGS; TREPK(1) ph_rowop<false, 1>(F, (const float*)args.in[0], (const float*)args.in[1], nullptr, nullptr, MOD, nullptr, 0, nullptr, 0 * 1024, 1 * 1024, (const float*)args.in[11], HN, nullptr); }
    SEAM(2);
    if (IN(3)) { PHASE_ARGS;
        PROJ1024(HN, 1024, ws + WS_WDQKV, 1024, 4, TMPb);
    }
    SEAM(3);
    if (IN(4)) { PHASE_ARGS; TREPK(2) ph_qkvpost(F, args); }
    SEAM(4);
    if (IN(5)) { PHASE_ARGS;
        pg8::Gemm g{(const pg8::bf16_t*)(ws + WS_CQ), (const pg8::bf16_t*)(ws + WS_WUQ), NR, 1536, QL, QL, 0, QL}; pg8::StaticOrder S; S.init(NR, 1536, F.G, (int)blockIdx.x);
        pg8::EpiQRope E{(pg8::bf16_t*)(ws + WS_QP), (const float*)(ws + WS_COS), (const float*)(ws + WS_SIN), (pg8::bf16_t*)(ws + WS_QD)};
        pg8::gemm_phase<pg8::EpiQRope, pg8::StaticOrder, true, true>(F.lds, g, S, E);
        pg8::Gemm g2{(const pg8::bf16_t*)(ws + WS_CQ) + (size_t)NPR * QL, (const pg8::bf16_t*)(ws + WS_WABS), NSR, 4096, QL, QL, 0, QL}; pg8::StaticOrder S2; S2.init(NSR, 4096, F.G, F.G - 1 - (int)blockIdx.x);
        pg8::EpiQD E2{(pg8::bf16_t*)(ws + WS_QD)};
        pg8::gemm_phase<pg8::EpiQD, pg8::StaticOrder, true, true>(F.lds, g2, S2, E2);
    }
    if (IN(6)) { PHASE_ARGS;
        pg8::Gemm g{(const pg8::bf16_t*)(ws + WS_CKV), (const pg8::bf16_t*)(ws + WS_WKVUP), NPR, 2048, KVL, KVL, 0, KVL}; pg8::StaticOrder S; S.init(NPR, 2048, F.G, (int)blockIdx.x);
        pg8::EpiBf16<0> E{(pg8::bf16_t*)(ws + WS_KN), 1024, nullptr, 1024, (size_t)(WS_VV - WS_KN) / 2, 1.f};
        pg8::gemm_phase<pg8::EpiBf16<0>, pg8::StaticOrder, true, true>(F.lds, g, S, E);
    }
    SEAM(6);
    if (IN(7)) { PHASE_ARGS; ph_attention(F, args); }
    SEAM(7);
    if (IN(8)) { PHASE_ARGS; TREPK(4) ph_dcombine(F, args); }
    SEAM(8);
    if (IN(9)) { PHASE_ARGS;
        PROJ1024(ws + WS_O, 1024, ws + WS_WO, 1024, 4, TMPb);
    }
    SEAM(9);
    if (IN(10)) { PHASE_ARGS; TREPK(1) ph_rowop<true, 1>(F, (const float*)args.in[0], (const float*)args.in[1], out, TMPb, MOD, nullptr, 2 * 1024, (const float*)args.in[12], 3 * 1024, 4 * 1024, (const float*)args.in[13], HN, nullptr, (const float*)(ws + WS_TMPS), 4, nullptr, (bf16*)(ws + WS_XB)); }
    SEAM(10);
    ffn_gemms(F, 0, 11, lo, hi, bar);
    if (IN(14)) { PHASE_ARGS; ph_rowop<true, 2>(F, out, out + (size_t)NPR * DM, out, TMPb, MOD, nullptr, 5 * 1024, (const float*)args.in[14], 6144 + 0 * 1024, 6144 + 1 * 1024, (const float*)args.in[11] + DM, (bf16*)(ws + WS_H1), out, (const float*)(ws + WS_TMPS), 11, (const bf16*)(ws + WS_XB), (bf16*)(ws + WS_XB)); }
    SEAM(14);
    if (IN(15)) { PHASE_ARGS; TREPK(6) ph_pool(F, args); }
    SEAM(15);
    if (IN(16)) { PHASE_ARGS;
        pg8::Gemm g{(const pg8::bf16_t*)(ws + WS_POOLED), (const pg8::bf16_t*)(ws + WS_POOLT), NR, 1024, 256, 1024, 256, 256}; pg8::StaticOrder S; S.init(NR, 1024, F.G, (int)blockIdx.x);
        pg8::EpiBf16<0> E{(pg8::bf16_t*)TMPb, 1024, nullptr, 0, 0, 1.f};
        pg8::gemm_phase<pg8::EpiBf16<0>, pg8::StaticOrder, true, true>(F.lds, g, S, E);
    }
    SEAM(16);
    if (IN(17)) { PHASE_ARGS; ph_rowop<true, 1>(F, out, out + (size_t)NPR * DM, out, TMPb, MOD, (const float*)args.in[24], 6144 + 2 * 1024, (const float*)args.in[12] + DM, 6144 + 3 * 1024, 6144 + 4 * 1024, (const float*)args.in[13] + DM, HN, nullptr, nullptr, 0, (const bf16*)(ws + WS_XB), (bf16*)(ws + WS_XB)); }
    SEAM(17);
    ffn_gemms(F, 1, 18, lo, hi, bar);
    if (IN(21)) { PHASE_ARGS; ph_rowop<true, 0>(F, out, out + (size_t)NPR * DM, out, TMPb, MOD, nullptr, 6144 + 5 * 1024, (const float*)args.in[14] + DM, 0, 0, nullptr, nullptr, nullptr, (const float*)(ws + WS_TMPS), 11, (const bf16*)(ws + WS_XB), nullptr); }
#undef IN
#undef SEAM
}

extern "C" void kernel_launch(void* const* d_in, const int* in_sizes, int n_in, void* d_out, int out_size, void* d_ws, size_t ws_size, hipStream_t stream) {
    static int grid = 0;
    if (grid == 0) {
        if (n_in != 29 || (size_t)out_size != OUT_TOTAL || ws_size < WS_END) { fprintf(stderr, "kernel_launch: unexpected shapes (n_in %d, out %d, ws %zu); nothing launched\n", n_in, out_size, ws_size); grid = -1; return; }
        int dev = 0, cus = 0, per_cu = 0;
        if (hipGetDevice(&dev) != hipSuccess || hipDeviceGetAttribute(&cus, hipDeviceAttributeMultiprocessorCount, dev) != hipSuccess) { grid = -1; return; }
        if (hipFuncSetAttribute((const void*)fwd, hipFuncAttributeMaxDynamicSharedMemorySize, LDS_BYTES) != hipSuccess) { fprintf(stderr, "kernel_launch: hipFuncSetAttribute failed\n"); grid = -1; return; }
        if (hipOccupancyMaxActiveBlocksPerMultiprocessor(&per_cu, (const void*)fwd, NWAVES * 64, LDS_BYTES) != hipSuccess || per_cu < 1) { fprintf(stderr, "kernel_launch: occupancy query reports %d workgroups per CU\n", per_cu); }
        (void)hipGetLastError();
        if (cus < 176) { fprintf(stderr, "kernel_launch: needs >= 176 CUs\n"); grid = -1; return; }
        grid = cus;
    }
    if (grid < 0) return;
    if (hipMemsetAsync((char*)d_ws + WS_CTL, 0, CTL_ZERO_BYTES, stream) != hipSuccess) return;
    Args a{};
    for (int i = 0; i < 29; ++i) a.in[i] = d_in[i];
    a.out = (float*)d_out; a.ws = (unsigned char*)d_ws;
#if MK_PER_PHASE
    for (int k = 0; k < NPHASES; ++k) { a.ph_lo = k; a.ph_hi = k + 1; hipLaunchKernelGGL(fwd, dim3(grid), dim3(NWAVES * 64), LDS_BYTES, stream, a);
#ifdef PROBE_PHASE_TWICE
        if (k == PROBE_PHASE_TWICE) hipLaunchKernelGGL(fwd, dim3(grid), dim3(NWAVES * 64), LDS_BYTES, stream, a);
#endif
    }
#else
    a.ph_lo = 0; a.ph_hi = NPHASES; hipLaunchKernelGGL(fwd, dim3(grid), dim3(NWAVES * 64), LDS_BYTES, stream, a);
#endif
}
```

```cpp
#include <hip/hip_runtime.h>
#include <cstdio>
#include <cstdint>
#include <cmath>
__device__ __forceinline__ int opaque_tid() { int t = threadIdx.x; asm volatile("" : "+v"(t)); return t; }
namespace pg8 {
#define PG8_LAS __attribute__((address_space(3)))
typedef unsigned short bf16_t;
typedef short bf16x8 __attribute__((ext_vector_type(8)));
typedef float f32x4 __attribute__((ext_vector_type(4)));
typedef unsigned u32x4 __attribute__((ext_vector_type(4)));
constexpr int BM = 256, BK = 64, HALF = 128, HTB = HALF * BK * 2  , STAGE_BYTES = 8 * HTB, NXCD = 8, WGM = 8;

__host__ __device__ __forceinline__ int lds_byte(int r, int c) { const int st = (r >> 4) * 2 + (c >> 5), rr = r & 15, cc = c & 31, ob = rr * 64 + cc * 2; return st * 1024 + (ob ^ (((ob >> 9) & 1) << 5)); }
__host__ __device__ __forceinline__ void stage_rc(int b, int& R, int& C) { const int st = b / 1024, sb = b % 1024, swz = sb ^ (((sb >> 9) & 1) << 5); R = (st >> 1) * 16 + swz / 64; C = (st & 1) * 32 + (swz % 64) / 2; }
__host__ __device__ __forceinline__ int perm32(int rho) { const int n = rho >> 4, i = rho & 15; return 8 * (i >> 2) + 4 * n + (i & 3); }

struct Unit { int pm, pn, pk, nt; };
struct Gemm { const bf16_t* A; const bf16_t* Bt; int M, N, K; int lda, agroup, ldb; };

struct StaticOrder {
    int nM, nN, nwg, G, c;
    __host__ __device__ void init(int M, int N, int G_, int c_) { nM = M / BM; nN = N / BM; nwg = nM * nN; G = G_; c = c_; }
    __host__ __device__ bool next(int i, Unit& u) const {
        const long L = (long)i * G + c; if (L >= nwg) return false;
        int wgid = (int)L; { const int q = nwg / NXCD, r = nwg % NXCD, xcd = wgid % NXCD, off = wgid / NXCD; wgid = (xcd < r ? xcd * (q + 1) : r * (q + 1) + (xcd - r) * q) + off; }
        const int nig = WGM * nN, gid = wgid / nig, fm = gid * WGM, gsz = (nM - fm) < WGM ? (nM - fm) : WGM;
        u.pm = fm + ((wgid % nig) % gsz); u.pn = (wgid % nig) / gsz; u.pk = 0; u.nt = 0; return true;
    }
    __device__ __forceinline__ void a_ready(const Unit&) const {}
    __device__ __forceinline__ void done(const Unit&) const {}
};

typedef float f32x2c __attribute__((ext_vector_type(2))); typedef __bf16 bf16x2c __attribute__((ext_vector_type(2)));
__device__ __forceinline__ unsigned cvt_pk_bf16(float lo, float hi) { const f32x2c v = {lo, hi}; const bf16x2c b = __builtin_convertvector(v, bf16x2c); return __builtin_bit_cast(unsigned, b); }
typedef float f32x2 __attribute__((ext_vector_type(2)));
__device__ __forceinline__ f32x2 gelu_pk(f32x2 v) {
    const f32x2 av = __builtin_elementwise_abs(v), d = av * 0.2316418882f + 1.0f;
    f32x2 t; t.x = __builtin_amdgcn_rcpf(d.x); t.y = __builtin_amdgcn_rcpf(d.y);
    f32x2 q = t * 0.5307027145f + (-0.7265760135f); q = q * t + 0.7107068705f; q = q * t + (-0.142248368f); q = q * t + 0.127414796f; q = q * t;
    const f32x2 s = (v * v) * (-0.72134752044f);
    f32x2 e; e.x = __builtin_amdgcn_exp2f(s.x); e.y = __builtin_amdgcn_exp2f(s.y);
    const f32x2 m = v * (q * e), r = v - m;
    f32x2 o; o.x = v.x < 0.f ? m.x : r.x; o.y = v.y < 0.f ? m.y : r.y; return o;
}

template <int ACT  > struct EpiBf16 {
    static constexpr bool PERM = true, AFTER_DRAIN = false; static_assert(ACT == 0 || ACT == 1, "EpiBf16: ACT is 0 (none) or 1 (gelu_pk)");
    bf16_t* O; int ldc; const float* bias; int split_cols; size_t split_stride; float scale0;
    __device__ __forceinline__ void operator()(const f32x4 (&acc)[2][2][4][2], const Unit& u, int wr, int wc, int fr, int fq) const {
        const int row0 = u.pm * BM + wr * 64 + fr; int colt = u.pn * BM; bf16_t* base = O;
        float sc = 1.f; if (split_cols) { const int t = colt / split_cols; base += (size_t)t * split_stride; colt -= t * split_cols; if (t == 0) sc = scale0; }
        const int col0 = colt + wc * 32 + 8 * fq, bcol0 = u.pn * BM + wc * 32 + 8 * fq;
        f32x4 bv[2][2];
#pragma unroll
        for (int bj = 0; bj < 2; ++bj)
#pragma unroll
            for (int n = 0; n < 2; ++n) bv[bj][n] = bias ? *(const f32x4*)(bias + bcol0 + bj * HALF + 4 * n) : (f32x4){0.f, 0.f, 0.f, 0.f};
#pragma unroll
        for (int ai = 0; ai < 2; ++ai)
#pragma unroll
            for (int m = 0; m < 4; ++m) { bf16_t* rowp = base + (size_t)(row0 + ai * HALF + m * 16) * ldc + col0;
#pragma unroll
                for (int bj = 0; bj < 2; ++bj) { f32x4 v0 = acc[ai][bj][m][0] + bv[bj][0], v1 = acc[ai][bj][m][1] + bv[bj][1];
                    if (ACT == 1) { f32x2 a = gelu_pk((f32x2){v0[0], v0[1]}), b = gelu_pk((f32x2){v0[2], v0[3]}), c = gelu_pk((f32x2){v1[0], v1[1]}), d = gelu_pk((f32x2){v1[2], v1[3]});
                        v0 = (f32x4){a.x, a.y, b.x, b.y}; v1 = (f32x4){c.x, c.y, d.x, d.y}; }
                    v0 = v0 * sc; v1 = v1 * sc; u32x4 w; w.x = cvt_pk_bf16(v0[0], v0[1]); w.y = cvt_pk_bf16(v0[2], v0[3]); w.z = cvt_pk_bf16(v1[0], v1[1]); w.w = cvt_pk_bf16(v1[2], v1[3]);
                    *(u32x4*)(rowp + bj * HALF) = w; } }
    }
};

struct EpiF32 {
    static constexpr bool PERM = false, AFTER_DRAIN = false;
    float* C; int ldc; const float* bias; const float* cscale; size_t kslab;
    __device__ __forceinline__ void operator()(const f32x4 (&acc)[2][2][4][2], const Unit& u, int wr, int wc, int fr, int fq) const {
        const int row0 = u.pm * BM + wr * 64 + fr, col0 = u.pn * BM + wc * 32 + 4 * fq;
        f32x4 bv[2][2], sv[2][2];
#pragma unroll
        for (int bj = 0; bj < 2; ++bj)
#pragma unroll
            for (int n = 0; n < 2; ++n) { bv[bj][n] = bias ? *(const f32x4*)(bias + col0 + bj * HALF + n * 16) : (f32x4){0.f, 0.f, 0.f, 0.f};
                sv[bj][n] = cscale ? *(const f32x4*)(cscale + col0 + bj * HALF + n * 16) : (f32x4){1.f, 1.f, 1.f, 1.f}; }
#pragma unroll
        for (int ai = 0; ai < 2; ++ai)
#pragma unroll
            for (int m = 0; m < 4; ++m) { float* rowp = C + (size_t)u.pk * kslab + (size_t)(row0 + ai * HALF + m * 16) * ldc + col0;
#pragma unroll
                for (int bj = 0; bj < 2; ++bj)
#pragma unroll
                    for (int n = 0; n < 2; ++n) *(f32x4*)(rowp + bj * HALF + n * 16) = (acc[ai][bj][m][n] + bv[bj][n]) * sv[bj][n]; }
    }
};
struct EpiQRope {
    static constexpr bool PERM = false, AFTER_DRAIN = false;
    bf16_t* O; const float* cosT; const float* sinT; bf16_t* QD;
    __device__ __forceinline__ void operator()(const f32x4 (&acc)[2][2][4][2], const Unit& u, int wr, int wc, int fr, int fq) const {
        const int row0 = u.pm * BM + wr * 64 + fr;
#pragma unroll
        for (int bj = 0; bj < 2; ++bj) {
            const int gb = u.pn * BM + bj * HALF + wc * 32; const bool rp = ((gb >> 5) % 3) == 2;
#pragma unroll
            for (int ai = 0; ai < 2; ++ai)
#pragma unroll
                for (int m = 0; m < 4; ++m) { const int row = row0 + ai * HALF + m * 16;
                    f32x4 v0 = acc[ai][bj][m][0], v1 = acc[ai][bj][m][1];
                    if (rp) { const int pos = row < 16384 ? (row & 8191) : 8192 + ((row - 16384) & 7);
                        const f32x4 c = *(const f32x4*)(cosT + pos * 16 + 4 * fq), s = *(const f32x4*)(sinT + pos * 16 + 4 * fq);
                        const f32x4 n0 = v0 * c - v1 * s, n1 = v1 * c + v0 * s; v0 = n0; v1 = n1; }
                    bf16_t* p = O + (size_t)row * 1536 + gb + 4 * fq;
                    typedef unsigned u32x2 __attribute__((ext_vector_type(2)));
                    u32x2 w0, w1; w0.x = cvt_pk_bf16(v0[0], v0[1]); w0.y = cvt_pk_bf16(v0[2], v0[3]); w1.x = cvt_pk_bf16(v1[0], v1[1]); w1.y = cvt_pk_bf16(v1[2], v1[3]);
                    *(u32x2*)p = w0; *(u32x2*)(p + 16) = w1;
                    if (rp && row >= 16384) { const int t = row - 16384, h = (gb >> 5) / 3; bf16_t* q = QD + ((size_t)(t >> 3) * 128 + (t & 7) * 16 + h) * 288 + 256 + 4 * fq; *(u32x2*)q = w0; *(u32x2*)(q + 16) = w1; } }
        }
    }
};


struct EpiQD {
    static constexpr bool PERM = true, AFTER_DRAIN = false;
    bf16_t* QD;
    __device__ __forceinline__ void operator()(const f32x4 (&acc)[2][2][4][2], const Unit& u, int wr, int wc, int fr, int fq) const {
        const int row0 = u.pm * BM + wr * 64 + fr, h = u.pn, col0 = wc * 32 + 8 * fq;
#pragma unroll
        for (int ai = 0; ai < 2; ++ai)
#pragma unroll
            for (int m = 0; m < 4; ++m) { const int t = row0 + ai * HALF + m * 16; bf16_t* base = QD + ((size_t)(t >> 3) * 128 + (t & 7) * 16 + h) * 288 + col0;
#pragma unroll
                for (int bj = 0; bj < 2; ++bj) { const f32x4 v0 = acc[ai][bj][m][0], v1 = acc[ai][bj][m][1];
                    u32x4 w; w.x = cvt_pk_bf16(v0[0], v0[1]); w.y = cvt_pk_bf16(v0[2], v0[3]); w.z = cvt_pk_bf16(v1[0], v1[1]); w.w = cvt_pk_bf16(v1[2], v1[3]);
                    *(u32x4*)(base + bj * HALF) = w; } }
    }
};
template <int S> struct SplitOrder {
    Unit u0; bool valid;
    __host__ __device__ void init(int N, int G_, int c_) { const int nN = N / BM; valid = c_ < 4 * nN * S; u0.pk = c_ % S; const int t = c_ / S; u0.pm = t & 3; u0.pn = t >> 2; u0.nt = 0; (void)G_; }
    __host__ __device__ bool next(int i, Unit& u) const { if (i > 0 || !valid) return false; u = u0; return true; }
    __device__ __forceinline__ void a_ready(const Unit&) const {}
    __device__ __forceinline__ void done(const Unit&) const {}
};


template <int S> struct HybridOrder {
    StaticOrder so; Unit us; bool has_s; int nt_full, nt_slice;
    __host__ __device__ void init(int Mp, int N, int Kfull, int G_, int c_) { so.init(Mp, N, G_, c_); nt_full = Kfull / BK; nt_slice = Kfull / S / BK;
        const int cs = G_ - 1 - c_, nN = N / BM; has_s = cs < 4 * nN * S; us.pk = cs % S; const int t = cs / S; us.pm = 64 + (t & 3); us.pn = t >> 2; us.nt = nt_slice; }
    __host__ __device__ bool next(int i, Unit& u) const { if (i == 0) { const bool ok = so.next(0, u); u.nt = nt_full; return ok; } if (i == 1 && has_s) { u = us; return true; } return false; }
    __device__ __forceinline__ void a_ready(const Unit&) const {}
    __device__ __forceinline__ void done(const Unit&) const {}
};
struct EpiHybrid {
    static constexpr bool PERM = true, AFTER_DRAIN = false;
    bf16_t* O; int ldc; float* slabs; size_t kslab;
    __device__ __forceinline__ void operator()(const f32x4 (&acc)[2][2][4][2], const Unit& u, int wr, int wc, int fr, int fq) const {
        const int col0 = u.pn * BM + wc * 32 + 8 * fq;
        if (u.pm < 64) { const int row0 = u.pm * BM + wr * 64 + fr;
#pragma unroll
            for (int ai = 0; ai < 2; ++ai)
#pragma unroll
                for (int m = 0; m < 4; ++m) { bf16_t* rowp = O + (size_t)(row0 + ai * HALF + m * 16) * ldc + col0;
#pragma unroll
                    for (int bj = 0; bj < 2; ++bj) { const f32x4 v0 = acc[ai][bj][m][0], v1 = acc[ai][bj][m][1];
                        u32x4 w; w.x = cvt_pk_bf16(v0[0], v0[1]); w.y = cvt_pk_bf16(v0[2], v0[3]); w.z = cvt_pk_bf16(v1[0], v1[1]); w.w = cvt_pk_bf16(v1[2], v1[3]);
                        *(u32x4*)(rowp + bj * HALF) = w; } }
        } else { const int row0 = (u.pm - 64) * BM + wr * 64 + fr; float* C = slabs + (size_t)u.pk * kslab;
#pragma unroll
            for (int ai = 0; ai < 2; ++ai)
#pragma unroll
                for (int m = 0; m < 4; ++m) { float* rowp = C + (size_t)(row0 + ai * HALF + m * 16) * 1024 + col0;
#pragma unroll
                    for (int bj = 0; bj < 2; ++bj) { *(f32x4*)(rowp + bj * HALF) = acc[ai][bj][m][0]; *(f32x4*)(rowp + bj * HALF + 4) = acc[ai][bj][m][1]; } }
        }
    }
};

template <class Epi, class Sched, bool ALIGN_EPI = false, bool SP2 = false>
__device__ __forceinline__ void gemm_phase(PG8_LAS unsigned char* lds, const Gemm g, const Sched& S, const Epi& E) {
    const int tid = opaque_tid(), wid = __builtin_amdgcn_readfirstlane(tid >> 6), lane = tid & 63, wr = wid >> 2, wc = wid & 3, fr = lane & 15, fq = lane >> 4;
    const int K = g.K; int nt = K / BK;
    unsigned voffA[2], voffB[2];
#pragma unroll
    for (int i = 0; i < 2; ++i) { int R, C; stage_rc(tid * 16 + i * 8192, R, C); const int Rb = Epi::PERM ? ((R & ~31) + perm32(R & 31)) : R;
        voffA[i] = (unsigned)(R * g.lda + C) * 2u; voffB[i] = (unsigned)(Rb * g.ldb + C) * 2u; }
    const size_t kstep = (size_t)(BK * 2);
    const size_t hstepA = (size_t)HALF * g.lda * 2, hstepB = (size_t)HALF * g.ldb * 2;
    const size_t tstepA = 2 * hstepA, tstepB = 2 * hstepB; const size_t gstepA = (size_t)g.agroup * 2, kstepS = (size_t)K * 2;
    const unsigned ldsw = (unsigned)wid * 1024u;
    const int aoff = lds_byte(wr * 64 + fr, fq * 8), boff = lds_byte(wc * 32 + fr, fq * 8);
#define PG8_SA(b, h) (((b) * 2 + (h)) * HTB)
#define PG8_SB(b, h) ((4 + (b) * 2 + (h)) * HTB)
#define PG8_STAGE(bufoff, gbase, voff) do { _Pragma("unroll") for (int _i = 0; _i < 2; ++_i) \
        __builtin_amdgcn_global_load_lds((const unsigned*)((const char*)(gbase) + (voff)[_i]), (PG8_LAS unsigned*)(lds + (bufoff) + ldsw + _i * 8192), 16, 0, 0); } while (0)
#define PG8_LDA(dst, b, h) do { _Pragma("unroll") for (int m = 0; m < 4; ++m) _Pragma("unroll") for (int k = 0; k < 2; ++k) dst[m][k] = *(const PG8_LAS bf16x8*)(lds + PG8_SA(b, h) + aoff + m * 2048 + k * 1024); } while (0)
#define PG8_LDB(dst, b, h) do { _Pragma("unroll") for (int n = 0; n < 2; ++n) _Pragma("unroll") for (int k = 0; k < 2; ++k) dst[n][k] = *(const PG8_LAS bf16x8*)(lds + PG8_SB(b, h) + boff + n * 2048 + k * 1024); } while (0)
#define PG8_MMA(ai, bj, At, Bt) do { __builtin_amdgcn_s_setprio(1); _Pragma("unroll") for (int m = 0; m < 4; ++m) _Pragma("unroll") for (int n = 0; n < 2; ++n) _Pragma("unroll") for (int k = 0; k < 2; ++k) \
        acc[ai][bj][m][n] = __builtin_amdgcn_mfma_f32_16x16x32_bf16(Bt[n][k], At[m][k], acc[ai][bj][m][n], 0, 0, 0); __builtin_amdgcn_s_setprio(0); } while (0)
#define PG8_WAIT_V(n) asm volatile("s_waitcnt vmcnt(" #n ")" ::: "memory")
#define PG8_WAIT_L(n) asm volatile("s_waitcnt lgkmcnt(" #n ")" ::: "memory")
#define PG8_BAR __builtin_amdgcn_s_barrier()
#define PG8_SCHED __builtin_amdgcn_sched_barrier(0)
    Unit cur, nxt; int ui = 0;
    if (!S.next(0, cur)) return;
    if (cur.nt > 0) nt = cur.nt;
    f32x4 acc[2][2][4][2];
#pragma unroll
    for (int a = 0; a < 2; ++a)
#pragma unroll
        for (int b = 0; b < 2; ++b)
#pragma unroll
            for (int m = 0; m < 4; ++m)
#pragma unroll
                for (int n = 0; n < 2; ++n) acc[a][b][m][n] = (f32x4){0.f, 0.f, 0.f, 0.f};
    bf16x8 At[4][2], B0[2][2], B1[2][2];
    const char* cA = (const char*)g.A + (size_t)cur.pm * tstepA + (size_t)cur.pn * gstepA + (size_t)cur.pk * kstepS; const char* cB = (const char*)g.Bt + (size_t)cur.pn * tstepB + (size_t)cur.pk * kstepS;
    S.a_ready(cur);
    if constexpr (SP2) {
        PG8_STAGE(PG8_SB(0, 0), cB, voffB); PG8_STAGE(PG8_SB(0, 1), cB + hstepB, voffB); PG8_STAGE(PG8_SA(0, 0), cA, voffA); PG8_STAGE(PG8_SA(0, 1), cA + hstepA, voffA);
        if (wr == 1) PG8_BAR;
        PG8_WAIT_V(2); PG8_BAR;
        PG8_STAGE(PG8_SB(1, 0), cB + kstep, voffB); PG8_STAGE(PG8_SA(1, 0), cA + kstep, voffA); PG8_STAGE(PG8_SB(1, 1), cB + hstepB + kstep, voffB);
        PG8_WAIT_V(6); PG8_BAR;
    } else {
        PG8_STAGE(PG8_SB(0, 0), cB, voffB); PG8_STAGE(PG8_SA(0, 0), cA, voffA); PG8_STAGE(PG8_SB(0, 1), cB + hstepB, voffB); PG8_STAGE(PG8_SA(0, 1), cA + hstepA, voffA);
        if (wr == 1) PG8_BAR;
        PG8_WAIT_V(4); PG8_BAR;
        PG8_STAGE(PG8_SB(1, 0), cB + kstep, voffB); PG8_STAGE(PG8_SA(1, 0), cA + kstep, voffA); PG8_STAGE(PG8_SB(1, 1), cB + hstepB + kstep, voffB);
        PG8_WAIT_V(6); PG8_BAR;
    }
    for (;;) {
        const bool has_next = S.next(ui + 1, nxt);
        const char* nA = has_next ? (const char*)g.A + (size_t)nxt.pm * tstepA + (size_t)nxt.pn * gstepA + (size_t)nxt.pk * kstepS : cA; const char* nB = has_next ? (const char*)g.Bt + (size_t)nxt.pn * tstepB + (size_t)nxt.pk * kstepS : cB;
        for (int t = 0; t < nt; t += 2) {
            const bool last = (t == nt - 2);
            const char* a1 = cA + (size_t)(t + 1) * kstep;
            const char* a2 = last ? nA : cA + (size_t)(t + 2) * kstep; const char* b2 = last ? nB : cB + (size_t)(t + 2) * kstep;
            const char* a3 = a2 + kstep; const char* b3 = b2 + kstep;
            if (last && has_next) S.a_ready(nxt);
            if constexpr (SP2) {
            PG8_LDB(B0, 0, 0); PG8_LDB(B1, 0, 1); PG8_SCHED; PG8_LDA(At, 0, 0); PG8_STAGE(PG8_SA(1, 1), a1 + hstepA, voffA);
            PG8_WAIT_V(8); PG8_WAIT_L(0); PG8_BAR; PG8_MMA(0, 0, At, B0); PG8_MMA(0, 1, At, B1); PG8_BAR; PG8_SCHED;
            PG8_LDA(At, 0, 1); PG8_STAGE(PG8_SB(0, 0), b2, voffB); PG8_STAGE(PG8_SB(0, 1), b2 + hstepB, voffB); PG8_STAGE(PG8_SA(0, 0), a2, voffA);
            PG8_WAIT_V(8); PG8_WAIT_L(0); PG8_BAR; PG8_MMA(1, 0, At, B0); PG8_MMA(1, 1, At, B1); PG8_BAR; PG8_SCHED;
            PG8_LDB(B0, 1, 0); PG8_LDB(B1, 1, 1); PG8_SCHED; PG8_LDA(At, 1, 0); PG8_STAGE(PG8_SA(0, 1), a2 + hstepA, voffA);
            PG8_WAIT_V(8); PG8_WAIT_L(0); PG8_BAR; PG8_MMA(0, 0, At, B0); PG8_MMA(0, 1, At, B1); PG8_BAR; PG8_SCHED;
            PG8_LDA(At, 1, 1); PG8_STAGE(PG8_SB(1, 0), b3, voffB); PG8_STAGE(PG8_SB(1, 1), b3 + hstepB, voffB); PG8_STAGE(PG8_SA(1, 0), a3, voffA);
            PG8_WAIT_V(8); PG8_WAIT_L(0); PG8_BAR; PG8_MMA(1, 0, At, B0); PG8_MMA(1, 1, At, B1); PG8_BAR; PG8_SCHED;
            } else {
            PG8_LDB(B0, 0, 0); PG8_SCHED; PG8_LDA(At, 0, 0); PG8_STAGE(PG8_SA(1, 1), a1 + hstepA, voffA);
            PG8_WAIT_L(8); PG8_BAR; PG8_WAIT_L(0); PG8_MMA(0, 0, At, B0); PG8_BAR; PG8_SCHED;
            PG8_LDB(B1, 0, 1); PG8_STAGE(PG8_SB(0, 0), b2, voffB);
            PG8_BAR; PG8_WAIT_L(0); PG8_MMA(0, 1, At, B1); PG8_BAR;
            PG8_LDA(At, 0, 1); PG8_STAGE(PG8_SA(0, 0), a2, voffA);
            PG8_BAR; PG8_WAIT_L(0); PG8_MMA(1, 0, At, B0); PG8_BAR; PG8_SCHED;
            PG8_STAGE(PG8_SB(0, 1), b2 + hstepB, voffB);
            PG8_WAIT_V(6); PG8_BAR; PG8_MMA(1, 1, At, B1); PG8_BAR;
            PG8_LDB(B0, 1, 0); PG8_SCHED; PG8_LDA(At, 1, 0); PG8_STAGE(PG8_SA(0, 1), a2 + hstepA, voffA);
            PG8_WAIT_L(8); PG8_BAR; PG8_WAIT_L(0); PG8_MMA(0, 0, At, B0); PG8_BAR; PG8_SCHED;
            PG8_LDB(B1, 1, 1); PG8_STAGE(PG8_SB(1, 0), b3, voffB);
            PG8_BAR; PG8_WAIT_L(0); PG8_MMA(0, 1, At, B1); PG8_BAR;
            PG8_LDA(At, 1, 1); PG8_STAGE(PG8_SA(1, 0), a3, voffA);
            PG8_BAR; PG8_WAIT_L(0); PG8_MMA(1, 0, At, B0); PG8_BAR; PG8_SCHED;
            PG8_STAGE(PG8_SB(1, 1), b3 + hstepB, voffB);
            PG8_WAIT_V(6); PG8_BAR; PG8_MMA(1, 1, At, B1); PG8_BAR;
            }
        }
        if constexpr (ALIGN_EPI) { if (wr == 0) PG8_BAR; }
        if constexpr (!Epi::AFTER_DRAIN) { E(acc, cur, wr, wc, fr, fq); S.done(cur); }
        if (!has_next) break;
#pragma unroll
        for (int a = 0; a < 2; ++a)
#pragma unroll
            for (int b = 0; b < 2; ++b)
#pragma unroll
                for (int m = 0; m < 4; ++m)
#pragma unroll
                    for (int n = 0; n < 2; ++n) acc[a][b][m][n] = (f32x4){0.f, 0.f, 0.f, 0.f};
        cur = nxt; cA = nA; cB = nB; ++ui; nt = (cur.nt > 0) ? cur.nt : K / BK;
        if constexpr (ALIGN_EPI) { if (wr == 1) PG8_BAR; }
    }
    PG8_WAIT_V(0);
    if constexpr (!ALIGN_EPI) { if (wr == 0) PG8_BAR; }
    PG8_BAR;
    if constexpr (Epi::AFTER_DRAIN) { E.fused(acc, cur, wr, wc, fr, fq, lds, wid, lane); S.done(cur); }
#undef PG8_SA
#undef PG8_SB
#undef PG8_STAGE
#undef PG8_LDA
#undef PG8_LDB
#undef PG8_MMA
#undef PG8_WAIT_V
#undef PG8_WAIT_L
#undef PG8_BAR
#undef PG8_SCHED
}
}

constexpr int NWAVES = 8;
constexpr int DM = 1024, TSEQ = 8192, NPR = 16384, NSR = 1024, NR = NPR + NSR;
constexpr int NDB = 128, NDS = 8, NH = 16, QL = 512, KVL = 256, RD = 32, FF = 2816, FF2 = 5632, NPAGE = 64;
constexpr float EPS = 1e-6f;
constexpr float SC2 = 0.10206207261596575f * 1.4426950408889634f;
constexpr size_t OUT_KVP = 17825792, OUT_KRP = 22020096, OUT_KVS = 22544384, OUT_KRS = 22806528, OUT_PSP = 22839296, OUT_PSS = 22870016, OUT_CSP = 24836096, OUT_CSS = 24881152, OUT_TOTAL = 27764736;
constexpr size_t MiB = 1u << 20;
constexpr size_t WS_CTL = 0, CTL_ZERO_BYTES = 1 * MiB;
constexpr size_t WS_COS = 1 * MiB, WS_SIN = 2 * MiB, WS_SILUC = 3 * MiB, WS_MOD = 4 * MiB, WS_ADAT = 16 * MiB, WS_WDQKV = 40 * MiB, WS_WUQ = 42 * MiB, WS_WKVUP = 44 * MiB, WS_WO = 45 * MiB,
                 WS_POOLT = 47 * MiB, WS_WUP = 48 * MiB, WS_WDOWN = 70 * MiB, WS_HN = 82 * MiB, WS_TMP = 116 * MiB, WS_CQ = 184 * MiB, WS_CKV = 201 * MiB, WS_KRB = 210 * MiB, WS_QP = 212 * MiB,
                 WS_KN = 264 * MiB, WS_VV = 296 * MiB, WS_O = 328 * MiB, WS_QD = 362 * MiB, WS_DPART = 372 * MiB, WS_DML = 404 * MiB, WS_U = 406 * MiB, WS_A2 = 594 * MiB, WS_H1 = 688 * MiB,
                 WS_POOLED = 756 * MiB, WS_XB = 722 * MiB, WS_WABS = 790 * MiB, WS_TMPS = 794 * MiB, WS_END = 840 * MiB;
constexpr int CW_BAR = 4096;
constexpr int RING_BYTES = 151552, LDSCTL_OFF = RING_BYTES, MISC_OFF = LDSCTL_OFF + 320, LDS_BYTES = 153600;

#define GAS __attribute__((address_space(1)))
#define LAS __attribute__((address_space(3)))
typedef unsigned short bf16;
typedef unsigned v4u __attribute__((ext_vector_type(4)));
typedef unsigned v2u __attribute__((ext_vector_type(2)));
typedef float f32x4 __attribute__((ext_vector_type(4)));
typedef float f32x2 __attribute__((ext_vector_type(2)));
typedef float f32x16 __attribute__((ext_vector_type(16)));
typedef short bf16x8 __attribute__((ext_vector_type(8)));
typedef short s16x4 __attribute__((ext_vector_type(4)));
typedef GAS unsigned gu32;
#define RLX_AGENT __ATOMIC_RELAXED, __HIP_MEMORY_SCOPE_AGENT
#define LDS_WAIT() asm volatile("s_waitcnt lgkmcnt(0)" ::: "memory")
#define VM_WAIT() asm volatile("s_waitcnt vmcnt(0)" ::: "memory")
__device__ __forceinline__ unsigned f2bf(float f) { unsigned u = __builtin_bit_cast(unsigned, f); return (u + 0x7fffu + ((u >> 16) & 1u)) >> 16; }

__device__ __forceinline__ float bf2f(unsigned h) { return __builtin_bit_cast(float, h << 16); }
__device__ __forceinline__ float bflo(unsigned w) { return __builtin_bit_cast(float, w << 16); }
__device__ __forceinline__ float bfhi(unsigned w) { return __builtin_bit_cast(float, w & 0xffff0000u); }
typedef __bf16 bf16x2_t __attribute__((ext_vector_type(2)));
__device__ __forceinline__ unsigned cvtpk(float lo, float hi) { const f32x2 v = {lo, hi}; const bf16x2_t b = __builtin_convertvector(v, bf16x2_t); return __builtin_bit_cast(unsigned, b); }
__device__ __forceinline__ unsigned pk2(float lo, float hi) { return cvtpk(lo, hi); }

#define XB_TMO      128
#define XB_XCNT(j)  (256  + 64 * (j))
#define XB_XSUB(j)  (1280 + 64 * (j))
#define XB_XGEN(j)  (2304 + 64 * (j))
#define XB_TOP      3328
#define XB_TOPGEN   3392
#define XCD_BAR_WORDS 3456
#define XB_SPIN_CAP (1u << 18)

__device__ __forceinline__ unsigned xb_ld(unsigned* p)              { return __hip_atomic_load(p, __ATOMIC_RELAXED, __HIP_MEMORY_SCOPE_AGENT); }
__device__ __forceinline__ unsigned xb_add(unsigned* p, unsigned v) { return __hip_atomic_fetch_add(p, v, __ATOMIC_RELAXED, __HIP_MEMORY_SCOPE_AGENT); }
__device__ __forceinline__ unsigned xb_xcc_id() { return (unsigned)__builtin_amdgcn_s_getreg((3 << 11) | 20) & 0xFu; }
#define XB_SPIN(cond, bar) do { unsigned _sp = 0; while (cond) { __builtin_amdgcn_s_sleep(1); \
    if ((++_sp & 255u) == 0u) { if (xb_ld(&(bar)[XB_TMO])) break; if (_sp > XB_SPIN_CAP) { atomicAdd(&(bar)[XB_TMO], 1u); break; } } } } while (0)

struct XcdBarrier {
    unsigned* bar; unsigned x;
    volatile LAS unsigned* st;
};

__device__ __forceinline__ XcdBarrier xcd_barrier_post(unsigned* bar, volatile LAS unsigned* st) {
    XcdBarrier b; b.bar = bar; b.x = xb_xcc_id(); b.st = st;
    if (threadIdx.x == 0) (void)xb_add(&bar[XB_XCNT(b.x)], 1u);
    return b;
}
__device__ __forceinline__ void xcd_barrier_complete(unsigned* bar, unsigned x, unsigned& nloc, unsigned& nx) {
    const unsigned G = gridDim.x * gridDim.y * gridDim.z;
    unsigned sum, cnt, mine, sp = 0u;
    for (;;) {
        sum = 0u; cnt = 0u; mine = 0u;
#pragma unroll
        for (unsigned j = 0; j < 16; ++j) { const unsigned c = xb_ld(&bar[XB_XCNT(j)]); sum += c; cnt += (c > 0u) ? 1u : 0u; mine = (j == x) ? c : mine; }
        if (sum == G) break;
        __builtin_amdgcn_s_sleep(1);
        if ((++sp & 255u) == 0u) { if (xb_ld(&bar[XB_TMO])) break; if (sp > XB_SPIN_CAP) { atomicAdd(&bar[XB_TMO], 1u); break; } }
    }
    nloc = mine > 0u ? mine : 1u; nx = cnt > 0u ? cnt : 1u;
}

__device__ __forceinline__ void xcd_barrier(const XcdBarrier& b) {
    asm volatile("s_waitcnt vmcnt(0)" ::: "memory");
    __syncthreads();
    if (threadIdx.x == 0) {
        unsigned* bar = b.bar;
        __builtin_amdgcn_s_waitcnt(0);
        unsigned nloc = b.st[0], nx = b.st[1];
        if (nloc == 0u) { xcd_barrier_complete(bar, b.x, nloc, nx); b.st[0] = nloc; b.st[1] = nx; }
        const unsigned old = xb_add(&bar[XB_XSUB(b.x)], 1u);
        const unsigned gen = old / nloc;
        if (old + 1u == (gen + 1u) * nloc) {
            __builtin_amdgcn_fence(__ATOMIC_RELEASE, "agent");
            asm volatile("s_waitcnt vmcnt(0)" ::: "memory");
            const unsigned og = xb_add(&bar[XB_TOP], 1u);
            const unsigned tg = og / nx;
            if (og + 1u == (tg + 1u) * nx) xb_add(&bar[XB_TOPGEN], 1u);
            else XB_SPIN(xb_ld(&bar[XB_TOPGEN]) == tg, bar);
            __builtin_amdgcn_fence(__ATOMIC_ACQUIRE, "agent");
            xb_add(&bar[XB_XGEN(b.x)], 1u);
            asm volatile("s_waitcnt vmcnt(0)" ::: "memory");
        } else {
            XB_SPIN(xb_ld(&bar[XB_XGEN(b.x)]) == gen, bar);
            __builtin_amdgcn_fence(__ATOMIC_ACQUIRE, "agent");
            asm volatile("s_waitcnt vmcnt(0)" ::: "memory");
        }
    }
    __syncthreads();
}

struct Args { const void* in[29]; float* out; unsigned char* ws; int ph_lo, ph_hi; };
struct Frame { LAS unsigned char* lds; volatile LAS unsigned* MISC; gu32* ctl; int tid, lane, wave, vcu, G; };

__device__ __forceinline__ float wave_sum(float v) {
#pragma unroll
    for (int o = 1; o < 64; o <<= 1) v += __shfl_xor(v, o);
    return v;
}
__device__ __forceinline__ float dot4(f32x4 a, f32x4 b) { return (a.x * b.x + a.y * b.y) + (a.z * b.z + a.w * b.w); }

__device__ __forceinline__ void p0_transpose_item(const float* W, int K, int N, bf16* WT, int row_off, LAS float* scr, int item, int lane) {
    const int nblk = N / 32, kb = item / nblk, nb = item % nblk, k0 = 64 * kb, n0 = 32 * nb;
#pragma unroll 8
    for (int i = 0; i < 32; ++i) { const int kk = 2 * i + (lane >> 5); scr[kk * 33 + (lane & 31)] = W[(size_t)(k0 + kk) * N + n0 + (lane & 31)]; }
    LDS_WAIT(); asm volatile("" ::: "memory");
    const int c = lane & 7;
#pragma unroll
    for (int j = 0; j < 4; ++j) { const int n = (lane >> 3) + 8 * j; const LAS float* s = scr + (8 * c) * 33 + n;
        v4u o; o.x = pk2(s[0 * 33], s[1 * 33]); o.y = pk2(s[2 * 33], s[3 * 33]); o.z = pk2(s[4 * 33], s[5 * 33]); o.w = pk2(s[6 * 33], s[7 * 33]);
        *(GAS v4u*)(WT + (size_t)(row_off + n0 + n) * K + k0 + 8 * c) = o; }
    LDS_WAIT(); asm volatile("" ::: "memory");
}

#ifndef DEFER_ALL
#define DEFER_ALL 0
#endif
template <int PART>
__device__ __forceinline__ void ph_prologue(const Frame& F, const Args& a, int wv, int nwv) {
    LAS float* scr = (LAS float*)(F.lds + F.wave * 16384);
    unsigned char* ws = a.ws;
    const int gw = wv, NGW = nwv;
    constexpr int I_ADA = 16 * 192, I_DQ = 16 * 16, I_DKV = 16 * 9, I_UQ = 8 * 48, I_UK = 4 * 32, I_WO = 16 * 32, I_POOL = 4 * 8, I_UP = 16 * 176, I_DOWN = 44 * 32;
    constexpr int NITEMS = 2 * I_ADA + I_DQ + I_DKV + I_UQ + 2 * I_UK + I_WO + 4 * I_POOL + 2 * I_UP + 2 * I_DOWN;
    constexpr int SPLIT = 2 * I_ADA + (DEFER_ALL ? 0 : 3584);
    for (int it = (PART == 0 ? gw : SPLIT + gw); it < (PART == 0 ? SPLIT : NITEMS); it += NGW) {
        int r = it;
        if (r < 2 * I_ADA) { const int l = r / I_ADA; p0_transpose_item((const float*)a.in[9] + (size_t)l * 1024 * 6144, 1024, 6144, (bf16*)(ws + WS_ADAT), l * 6144, scr, r % I_ADA, F.lane); continue; } r -= 2 * I_ADA;
        if (r < I_DQ) { p0_transpose_item((const float*)a.in[15], 1024, 512, (bf16*)(ws + WS_WDQKV), 0, scr, r, F.lane); continue; } r -= I_DQ;
        if (r < I_DKV) { p0_transpose_item((const float*)a.in[18], 1024, 288, (bf16*)(ws + WS_WDQKV), 512, scr, r, F.lane); continue; } r -= I_DKV;
        if (r < I_UQ) { p0_transpose_item((const float*)a.in[17], 512, 1536, (bf16*)(ws + WS_WUQ), 0, scr, r, F.lane); continue; } r -= I_UQ;
        if (r < I_UK) { p0_transpose_item((const float*)a.in[20], 256, 1024, (bf16*)(ws + WS_WKVUP), 0, scr, r, F.lane); continue; } r -= I_UK;
        if (r < I_UK) { p0_transpose_item((const float*)a.in[21], 256, 1024, (bf16*)(ws + WS_WKVUP), 1024, scr, r, F.lane); continue; } r -= I_UK;
        if (r < I_WO) { p0_transpose_item((const float*)a.in[22], 1024, 1024, (bf16*)(ws + WS_WO), 0, scr, r, F.lane); continue; } r -= I_WO;
        if (r < 4 * I_POOL) { const int g = r / I_POOL; p0_transpose_item((const float*)a.in[23] + (size_t)g * 65536, 256, 256, (bf16*)(ws + WS_POOLT), g * 256, scr, r % I_POOL, F.lane); continue; } r -= 4 * I_POOL;
        if (r < 2 * I_UP) { const int l = r / I_UP; p0_transpose_item((const float*)a.in[25] + (size_t)l * 1024 * FF2, 1024, FF2, (bf16*)(ws + WS_WUP) + (size_t)l * FF2 * 1024, 0, scr, r % I_UP, F.lane); continue; } r -= 2 * I_UP;
        { const int l = r / I_DOWN; p0_transpose_item((const float*)a.in[28] + (size_t)l * FF * 1024, FF, 1024, (bf16*)(ws + WS_WDOWN) + (size_t)l * 1024 * FF, 0, scr, r % I_DOWN, F.lane); }
    }
    if (PART == 1)
    for (int it = NGW - 1 - gw; it < 512; it += NGW) { const int h = it >> 5, kb = (it >> 3) & 3, cb = it & 7; const float* wuq = (const float*)a.in[17]; const float* wuk = (const float*)a.in[20];
#pragma unroll 8
        for (int i = 0; i < 64; ++i) scr[i * 64 + F.lane] = wuq[(size_t)(cb * 64 + i) * 1536 + h * 96 + F.lane];
        f32x4 wk[16];
#pragma unroll
        for (int n = 0; n < 16; ++n) wk[n] = *(const f32x4*)(wuk + (size_t)(kb * 64 + F.lane) * 1024 + h * 64 + 4 * n);
        LDS_WAIT(); asm volatile("" ::: "memory");
#pragma unroll 1
        for (int c2 = 0; c2 < 32; ++c2) { float s0 = 0.f, s1 = 0.f; const LAS float* q = scr + c2 * 128;
#pragma unroll
            for (int n = 0; n < 16; ++n) { s0 += dot4(wk[n], *(const LAS f32x4*)(q + 4 * n)); s1 += dot4(wk[n], *(const LAS f32x4*)(q + 64 + 4 * n)); }
            *(GAS unsigned*)((bf16*)(ws + WS_WABS) + (size_t)(h * 256 + kb * 64 + F.lane) * 512 + cb * 64 + c2 * 2) = pk2(s0, s1); }
        LDS_WAIT(); asm volatile("" ::: "memory");
    }
    const int gt = gw * 64 + F.lane, NGT = NGW * 64;
    if (PART == 1) for (int i = gt; i < 224 * 128; i += NGT) *(GAS v4u*)(ws + WS_WDQKV + (size_t)800 * 2048 + (size_t)i * 16) = (v4u){0u, 0u, 0u, 0u};
    if (PART == 1) return;
    for (int i = gt; i < 256 * 128; i += NGT) { const int r = i >> 7, d = (i & 127) * 8; v4u o = (v4u){0u, 0u, 0u, 0u};
        if (r < 130) { const float* c = r < 2 ? (const float*)a.in[7] + r * 1024 + d : (const float*)a.in[8] + (r - 2) * 1024 + d; float v[8];
#pragma unroll
            for (int e = 0; e < 8; ++e) { const float x = c[e]; v[e] = x / (1.f + __expf(-x)); }
            o.x = pk2(v[0], v[1]); o.y = pk2(v[2], v[3]); o.z = pk2(v[4], v[5]); o.w = pk2(v[6], v[7]); }
        *(GAS v4u*)(ws + WS_SILUC + (size_t)i * 16) = o; }
    for (int i = gt; i < 8200 * 16; i += NGT) { const int pos = i >> 4, k = i & 15;
        const double inv = exp2(-(double)k * (13.287712379549449 / 16.0)); const double ang = (double)pos * inv;
        const double kk = rint(ang * 0.15915494309189535); double r = fma(-kk, 6.283185307179586, ang); r = fma(-kk, 2.4492935982947064e-16, r);
        const double r2 = r * r; double s = 1.0, c = 1.0;
#pragma unroll
        for (int n = 13; n >= 1; --n) { s = 1.0 - s * r2 * (1.0 / ((2.0 * n) * (2.0 * n + 1.0))); c = 1.0 - c * r2 * (1.0 / ((2.0 * n - 1.0) * (2.0 * n))); }
        s *= r;
        ((float*)(ws + WS_COS))[i] = (float)c; ((float*)(ws + WS_SIN))[i] = (float)s; }
}

template <bool HAS_Y>
__device__ __forceinline__ void rowop_load(int row, int lane, const float* xa, const float* xb, const bf16* XB, const bf16* Yb, bool has_ys, const f32x4 (&ysc)[4], const float* YS, int nsplit, f32x4 (&x)[4], f32x4 (&y)[4]) {
    if (XB) {
#pragma unroll
        for (int j = 0; j < 4; ++j) { const v2u v = *(const v2u*)(XB + (size_t)row * DM + 4 * lane + 256 * j); x[j] = (f32x4){bflo(v.x), bfhi(v.x), bflo(v.y), bfhi(v.y)}; }
    } else { const float* xr = row < NPR ? xa + (size_t)row * DM : xb + (size_t)(row - NPR) * DM;
#pragma unroll
        for (int j = 0; j < 4; ++j) x[j] = *(const f32x4*)(xr + 4 * lane + 256 * j); }
    if (HAS_Y) {
#pragma unroll
        for (int j = 0; j < 4; ++j) {
            if (row < NPR || nsplit == 0) { const v2u v = *(const v2u*)(Yb + (size_t)row * DM + 4 * lane + 256 * j); y[j] = (f32x4){bflo(v.x), bfhi(v.x), bflo(v.y), bfhi(v.y)}; }
            else { y[j] = (f32x4){0.f, 0.f, 0.f, 0.f};
                for (int s = 0; s < nsplit; ++s) y[j] = y[j] + *(const f32x4*)(YS + ((size_t)s * NSR + (row - NPR)) * DM + 4 * lane + 256 * j); }
            if (has_ys) y[j] = y[j] * ysc[j]; }
    }
}
struct ModVec { f32x4 g[4], sc[4], sh[4]; int bi; };
template <bool HAS_Y, int OUTM>
__device__ __forceinline__ void modvec_load(ModVec& mv, int bi, int lane, const float* MOD, int og, int osh, int osc) {
    if (bi == mv.bi) return;
    const float* modr = MOD + (size_t)bi * 12288; mv.bi = bi;
#pragma unroll
    for (int j = 0; j < 4; ++j) { const int d = 4 * lane + 256 * j;
        if (HAS_Y) mv.g[j] = *(const f32x4*)(modr + og + d);
        if (OUTM != 0) { mv.sc[j] = *(const f32x4*)(modr + osc + d); mv.sh[j] = *(const f32x4*)(modr + osh + d); } }
}
template <bool HAS_Y, int OUTM>
__device__ __forceinline__ void rowop_finish(int row, int lane, f32x4 (&x)[4], const f32x4 (&y)[4], float* X, bf16* XBo, const ModVec& mv, const f32x4 (&wpo)[4], const f32x4 (&wpr)[4], bf16* HN, float* out) {
    if (HAS_Y) {
        float ss = 0.f;
#pragma unroll
        for (int j = 0; j < 4; ++j) ss += dot4(y[j], y[j]);
        const float r = 1.f / sqrtf(wave_sum(ss) * (1.f / DM) + EPS);
#pragma unroll
        for (int j = 0; j < 4; ++j) {
            x[j] = x[j] + mv.g[j] * (y[j] * r * wpo[j]);
            if (XBo) { v2u o; o.x = pk2(x[j].x, x[j].y); o.y = pk2(x[j].z, x[j].w); *(v2u*)(XBo + (size_t)row * DM + 4 * lane + 256 * j) = o; x[j] = (f32x4){bflo(o.x), bfhi(o.x), bflo(o.y), bfhi(o.y)}; }
            else *(f32x4*)(X + (size_t)row * DM + 4 * lane + 256 * j) = x[j]; }
    }
    if (OUTM != 0) {
        float ss = 0.f;
#pragma unroll
        for (int j = 0; j < 4; ++j) ss += dot4(x[j], x[j]);
        const float r = 1.f / sqrtf(wave_sum(ss) * (1.f / DM) + EPS);
        float* st = nullptr;
        if (OUTM == 2) { if (row >= NPR) st = out + OUT_PSS + ((size_t)((row - NPR) >> 3) * 15 + 7 + ((row - NPR) & 7)) * DM;
                         else if ((row & 8191) >= 8177) st = out + OUT_PSP + ((size_t)(row >> 13) * 15 + ((row & 8191) - 8177)) * DM; }
#pragma unroll
        for (int j = 0; j < 4; ++j) { const int d = 4 * lane + 256 * j;
            const f32x4 h = (x[j] * r * wpr[j]) * (mv.sc[j] + 1.f) + mv.sh[j];
            v2u o; o.x = pk2(h.x, h.y); o.y = pk2(h.z, h.w); *(v2u*)(HN + (size_t)row * DM + d) = o;
            if (OUTM == 2 && st) *(f32x4*)(st + d) = h; }
    }
}
template <bool HAS_Y, int OUTM>
__device__ __forceinline__ void ph_rowop(const Frame& F, const float* xa, const float* xb, float* X, const bf16* Yb, const float* MOD, const float* yscale, int og, const float* wpost,
                                         int osh, int osc, const float* wpre, bf16* HN, float* out, const float* YS = nullptr, int nsplit = 0, const bf16* XBi = nullptr, bf16* XBo = nullptr) {
    const int gw = F.vcu * NWAVES + F.wave, NGW = F.G * NWAVES, lane = F.lane;
    f32x4 wpo[4], wpr[4];
#pragma unroll
    for (int j = 0; j < 4; ++j) { wpo[j] = HAS_Y ? *(const f32x4*)(wpost + 4 * lane + 256 * j) : (f32x4){0.f, 0.f, 0.f, 0.f}; wpr[j] = OUTM != 0 ? *(const f32x4*)(wpre + 4 * lane + 256 * j) : (f32x4){0.f, 0.f, 0.f, 0.f}; }
    ModVec mv; mv.bi = -1;
    f32x4 ysc[4]; const bool has_ys = yscale != nullptr;
#pragma unroll
    for (int j = 0; j < 4; ++j) ysc[j] = has_ys ? *(const f32x4*)(yscale + 4 * lane + 256 * j) : (f32x4){1.f, 1.f, 1.f, 1.f};
    for (int row = gw; row < NR; row += 2 * NGW) {
        const int row2 = row + NGW; const bool two = row2 < NR;
        f32x4 x0[4], y0[4], x1[4], y1[4];
        rowop_load<HAS_Y>(row, lane, xa, xb, XBi, Yb, has_ys, ysc, YS, nsplit, x0, y0);
        if (two) rowop_load<HAS_Y>(row2, lane, xa, xb, XBi, Yb, has_ys, ysc, YS, nsplit, x1, y1);
        modvec_load<HAS_Y, OUTM>(mv, row < NPR ? (row >> 13) : 2 + ((row - NPR) >> 3), lane, MOD, og, osh, osc);
        rowop_finish<HAS_Y, OUTM>(row, lane, x0, y0, X, XBo, mv, wpo, wpr, HN, out);
        if (two) { modvec_load<HAS_Y, OUTM>(mv, row2 < NPR ? (row2 >> 13) : 2 + ((row2 - NPR) >> 3), lane, MOD, og, osh, osc);
                   rowop_finish<HAS_Y, OUTM>(row2, lane, x1, y1, X, XBo, mv, wpo, wpr, HN, out); }
    }
}

__device__ __forceinline__ void ph_qkvpost(const Frame& F, const Args& a) {
    unsigned char* ws = a.ws; const float* TMP = (const float*)(ws + WS_TMP); const float* qn = (const float*)a.in[16]; const float* kvn = (const float*)a.in[19];
    const float* cosT = (const float*)(ws + WS_COS); const float* sinT = (const float*)(ws + WS_SIN);
    bf16* CQ = (bf16*)(ws + WS_CQ); bf16* CKV = (bf16*)(ws + WS_CKV); bf16* KRB = (bf16*)(ws + WS_KRB); float* out = a.out;
    const int gw = F.vcu * NWAVES + F.wave, NGW = F.G * NWAVES, lane = F.lane;
    const f32x4 w0 = *(const f32x4*)(qn + 4 * lane), w1 = *(const f32x4*)(qn + 256 + 4 * lane), wk = *(const f32x4*)(kvn + 4 * lane);
    for (int row = gw; row < NR; row += NGW) {
        const float* t = (const float*)(ws + WS_TMPS) + (size_t)(row - NPR) * 1024;
        f32x4 a0, a1, kk; float x1 = 0.f, x2 = 0.f;
        if (row < NPR) { const bf16* tb = (const bf16*)TMP + (size_t)row * 1024; const v2u v0 = *(const v2u*)(tb + 4 * lane), v1 = *(const v2u*)(tb + 256 + 4 * lane), v2 = *(const v2u*)(tb + 512 + 4 * lane);
            a0 = (f32x4){bflo(v0.x), bfhi(v0.x), bflo(v0.y), bfhi(v0.y)}; a1 = (f32x4){bflo(v1.x), bfhi(v1.x), bflo(v1.y), bfhi(v1.y)}; kk = (f32x4){bflo(v2.x), bfhi(v2.x), bflo(v2.y), bfhi(v2.y)};
            if (lane < 16) { x1 = bf2f(tb[768 + lane]); x2 = bf2f(tb[784 + lane]); } }
        else { a0 = *(const f32x4*)(t + 4 * lane); a1 = *(const f32x4*)(t + 256 + 4 * lane); kk = *(const f32x4*)(t + 512 + 4 * lane); if (lane < 16) { x1 = t[768 + lane]; x2 = t[784 + lane]; } }
        if (row >= NPR) {
#pragma unroll
            for (int s = 1; s < 4; ++s) { const float* ts = t + (size_t)s * NSR * 1024; a0 = a0 + *(const f32x4*)(ts + 4 * lane); a1 = a1 + *(const f32x4*)(ts + 256 + 4 * lane); kk = kk + *(const f32x4*)(ts + 512 + 4 * lane);
                if (lane < 16) { x1 += ts[768 + lane]; x2 += ts[784 + lane]; } } }
        const float rq = 1.f / sqrtf(wave_sum(dot4(a0, a0) + dot4(a1, a1)) * (1.f / QL) + EPS);
        const float rk = 1.f / sqrtf(wave_sum(dot4(kk, kk)) * (1.f / KVL) + EPS);
        const f32x4 c0 = a0 * rq * w0, c1 = a1 * rq * w1, ck = kk * rk * wk;
        v2u o; o.x = pk2(c0.x, c0.y); o.y = pk2(c0.z, c0.w); *(v2u*)(CQ + (size_t)row * QL + 4 * lane) = o;
        o.x = pk2(c1.x, c1.y); o.y = pk2(c1.z, c1.w); *(v2u*)(CQ + (size_t)row * QL + 256 + 4 * lane) = o;
        float* okv = row < NPR ? out + OUT_KVP + (size_t)row * KVL : out + OUT_KVS + (size_t)(row - NPR) * KVL;
        *(f32x4*)(okv + 4 * lane) = ck;
        o.x = pk2(ck.x, ck.y); o.y = pk2(ck.z, ck.w); *(v2u*)(CKV + (size_t)row * KVL + 4 * lane) = o;
        if (lane < 16) { const int pos = row < NPR ? (row & 8191) : 8192 + ((row - NPR) & 7);
            const float c = cosT[pos * 16 + lane], s = sinT[pos * 16 + lane]; const float o1 = x1 * c - x2 * s, o2 = x2 * c + x1 * s;
            float* okr = row < NPR ? out + OUT_KRP + (size_t)row * RD : out + OUT_KRS + (size_t)(row - NPR) * RD;
            okr[lane] = o1; okr[16 + lane] = o2; KRB[(size_t)row * RD + lane] = (bf16)f2bf(o1); KRB[(size_t)row * RD + 16 + lane] = (bf16)f2bf(o2); }
    }
}

__device__ __forceinline__ s16x4 trrd(LAS unsigned char* p) { typedef short v4i16_t __attribute__((ext_vector_type(4))); return __builtin_bit_cast(s16x4, __builtin_amdgcn_ds_read_tr16_b64_v4i16((LAS v4i16_t*)p)); }
__device__ __forceinline__ bf16x8 cat8(s16x4 lo, s16x4 hi) { return (bf16x8){lo[0], lo[1], lo[2], lo[3], hi[0], hi[1], hi[2], hi[3]}; }
__device__ __forceinline__ bf16x8 pack8(float a0, float a1, float a2, float a3, float a4, float a5, float a6, float a7) {
    v4u w; w.x = cvtpk(a0, a1); w.y = cvtpk(a2, a3); w.z = cvtpk(a4, a5); w.w = cvtpk(a6, a7); return __builtin_bit_cast(bf16x8, w); }
#define EXP2(x) __builtin_amdgcn_exp2f(x)
#ifndef RESC_TAU
#define RESC_TAU 8.f
#endif

__device__ __forceinline__ float max3f(float a, float b, float c) { float r; asm volatile("v_max3_f32 %0, %1, %2, %3" : "=v"(r) : "v"(a), "v"(b), "v"(c)); return r; }
__device__ __forceinline__ float hmax32(float v) { auto rr = __builtin_amdgcn_permlane32_swap(__float_as_uint(v), __float_as_uint(v), false, false); return fmaxf(__uint_as_float(rr[0]), __uint_as_float(rr[1])); }
__device__ __forceinline__ void pattn_unit(LAS unsigned char* lds, const bf16* QP, const bf16* KN, const bf16* KRB, const bf16* VV, bf16* O, int b, int h, int qb) {
    const int tid = opaque_tid(), lane = tid & 63, wid = __builtin_amdgcn_readfirstlane(tid >> 6), r32 = lane & 31, hi = lane >> 5;
    constexpr int KP = 208, VP = 192, KBUF = 64 * KP, VBUF = 64 * VP, OFF_V = 2 * KBUF;
    const size_t rowb = (size_t)b * TSEQ; const int qw = qb * 256 + wid * 32;
    constexpr int OFF_Q = OFF_V + 2 * VBUF;
    LAS unsigned char* Qw = lds + OFF_Q + (wid * 32 + r32) * KP + hi * 16;
    { const bf16* qp = QP + (rowb + qw + r32) * 1536 + h * 96 + hi * 8;
#pragma unroll
      for (int d0 = 0; d0 < 6; ++d0) *(LAS bf16x8*)(Qw + d0 * 32) = *(const bf16x8*)(qp + d0 * 16); }
    const int lrow = tid >> 3, lch = tid & 7, rrow = (tid & 255) >> 2, rch = tid & 3; const bool hasr = tid < 256;
    const bf16* gkn = KN + (rowb + lrow) * 1024 + h * 64 + lch * 8;
    const bf16* gvv = VV + (rowb + lrow) * 1024 + h * 64 + lch * 8;
    const bf16* gkr = KRB + (rowb + rrow) * RD + rch * 8;
    const unsigned wK = lrow * KP + lch * 16, wV = OFF_V + lrow * VP + lch * 16, wR = rrow * KP + 128 + rch * 16;
    const int NT = 4 * qb + 4;
    const int q4 = (lane & 15) >> 2, p4 = lane & 3, blk = (lane >> 4) & 1;
    const unsigned vlane = (4 * hi + q4) * VP + (16 * blk + 4 * p4) * 2, klane = r32 * KP + hi * 16;
    const int qrel = wid * 32 + r32;
#define PA_QK(Kb, s0, s1) do { _Pragma("unroll") for (int r_ = 0; r_ < 16; ++r_) { s0[r_] = 0.f; s1[r_] = 0.f; } \
        _Pragma("unroll") for (int d0 = 0; d0 < 6; ++d0) { const bf16x8 q_ = *(const LAS bf16x8*)(Qw + d0 * 32), a0_ = *(const LAS bf16x8*)((Kb) + klane + d0 * 32), a1_ = *(const LAS bf16x8*)((Kb) + klane + 32 * KP + d0 * 32); \
            s0 = __builtin_amdgcn_mfma_f32_32x32x16_bf16(a0_, q_, s0, 0, 0, 0); s1 = __builtin_amdgcn_mfma_f32_32x32x16_bf16(a1_, q_, s1, 0, 0, 0); } } while (0)
#define PA_SOFTMAX(jt, s0, s1) do { \
        if ((jt) >= 4 * qb) { const int kb_ = 64 * ((jt) - 4 * qb) + 4 * hi; \
            _Pragma("unroll") for (int r_ = 0; r_ < 16; ++r_) { const int kv_ = kb_ + (r_ & 3) + 8 * (r_ >> 2); if (kv_ > qrel) s0[r_] = -INFINITY; if (kv_ + 32 > qrel) s1[r_] = -INFINITY; } } \
        float rm_ = fmaxf(s0[0], s1[0]); \
        _Pragma("unroll") for (int r_ = 1; r_ < 16; ++r_) rm_ = fmaxf(rm_, fmaxf(s0[r_], s1[r_])); \
        rm_ = hmax32(rm_) * SC2; \
        if (__any(rm_ > m)) { const float mn_ = fmaxf(m, rm_), al_ = EXP2(m - mn_); m = mn_; l *= al_; \
            _Pragma("unroll") for (int r_ = 0; r_ < 16; ++r_) { o0[r_] *= al_; o1[r_] *= al_; } } \
        float ps_ = 0.f; \
        _Pragma("unroll") for (int r_ = 0; r_ < 16; ++r_) { s0[r_] = EXP2(__builtin_fmaf(s0[r_], SC2, -m)); s1[r_] = EXP2(__builtin_fmaf(s1[r_], SC2, -m)); ps_ += s0[r_] + s1[r_]; } \
        l += ps_; \
        pf[0] = pack8(s0[0], s0[1], s0[2], s0[3], s0[4], s0[5], s0[6], s0[7]); pf[1] = pack8(s0[8], s0[9], s0[10], s0[11], s0[12], s0[13], s0[14], s0[15]); \
        pf[2] = pack8(s1[0], s1[1], s1[2], s1[3], s1[4], s1[5], s1[6], s1[7]); pf[3] = pack8(s1[8], s1[9], s1[10], s1[11], s1[12], s1[13], s1[14], s1[15]); } while (0)
#define PA_PV(Vb) do { _Pragma("unroll") for (int s_ = 0; s_ < 4; ++s_) { \
            { const bf16x8 vf_ = cat8(trrd((Vb) + vlane + (16 * s_) * VP), trrd((Vb) + vlane + (16 * s_ + 8) * VP)); o0 = __builtin_amdgcn_mfma_f32_32x32x16_bf16(vf_, pf[s_], o0, 0, 0, 0); } \
            { const bf16x8 vf_ = cat8(trrd((Vb) + vlane + (16 * s_) * VP + 64), trrd((Vb) + vlane + (16 * s_ + 8) * VP + 64)); o1 = __builtin_amdgcn_mfma_f32_32x32x16_bf16(vf_, pf[s_], o1, 0, 0, 0); } } } while (0)
#ifdef PROBE_PRO_QK2
#define PA_PROBE(Kb) do { f32x16 t0_, t1_; unsigned z_ = 0; asm volatile("" : "+v"(z_)); PA_QK((Kb) + z_, t0_, t1_); _Pragma("unroll") for (int r_ = 0; r_ < 16; ++r_) { sA0[r_] += (t0_[r_] - t0_[r_]); sA1[r_] += (t1_[r_] - t1_[r_]); } } while (0)
#elif defined(PROBE_PRO_SM2)
#define PA_PROBE(Kb) do { float x_ = 0.f; asm volatile("" : "+v"(x_)); _Pragma("unroll") for (int r_ = 0; r_ < 16; ++r_) { x_ += EXP2(__builtin_fmaf(sA0[r_], SC2, x_)) + EXP2(__builtin_fmaf(sA1[r_], SC2, -x_)); } l += (x_ - x_); } while (0)
#else
#define PA_PROBE(Kb) do {} while (0)
#endif
    float m = -INFINITY, l = 0.f; f32x16 o0, o1, sA0, sA1, sB0, sB1; bf16x8 pf[4], pfp[4];
#pragma unroll
    for (int r = 0; r < 16; ++r) { o0[r] = 0.f; o1[r] = 0.f; }
    v4u rkA, rvA, rrA;
#define PA_LOAD(rk_, rv_, rr_, kt, vt) do { if ((kt) < NT) { const size_t adv_ = (size_t)(kt) * 64; rk_ = *(const v4u*)(gkn + adv_ * 1024); if (hasr) rr_ = *(const v4u*)(gkr + adv_ * RD); } \
        if ((vt) < NT) { const size_t adv_ = (size_t)(vt) * 64; rv_ = *(const v4u*)(gvv + adv_ * 1024); } } while (0)
#define PA_STORE(rk_, rv_, rr_, kt, vt) do { if ((kt) < NT) { *(LAS v4u*)(lds + ((kt) & 1) * KBUF + wK) = rk_; if (hasr) *(LAS v4u*)(lds + ((kt) & 1) * KBUF + wR) = rr_; } \
        if ((vt) < NT) *(LAS v4u*)(lds + ((vt) & 1) * VBUF + wV) = rv_; } while (0)
#define PA_SM2(jt, MASKM, s0, s1, al_, resc_) do { \
        if ((MASKM) == 1 || ((MASKM) == 2 && (jt) >= 4 * qb)) { const int kb_ = 64 * ((jt) - 4 * qb) + 4 * hi; \
            _Pragma("unroll") for (int r_ = 0; r_ < 16; ++r_) { const int kv_ = kb_ + (r_ & 3) + 8 * (r_ >> 2); if (kv_ > qrel) s0[r_] = -INFINITY; if (kv_ + 32 > qrel) s1[r_] = -INFINITY; } } \
        float rm_ = max3f(s0[0], s1[0], s0[1]), rn_ = max3f(s1[1], s0[2], s1[2]); \
        _Pragma("unroll") for (int r_ = 3; r_ < 15; r_ += 2) { rm_ = max3f(rm_, s0[r_], s1[r_]); rn_ = max3f(rn_, s0[r_ + 1], s1[r_ + 1]); } \
        rm_ = max3f(rm_, rn_, s0[15]); rm_ = fmaxf(rm_, s1[15]); \
        rm_ = hmax32(rm_) * SC2; \
        resc_ = __any(rm_ > m + RESC_TAU); al_ = 1.f; \
        if (resc_) { const float mn_ = fmaxf(m, rm_); al_ = EXP2(m - mn_); m = mn_; l *= al_; } \
        float ps_ = 0.f; \
        _Pragma("unroll") for (int r_ = 0; r_ < 16; ++r_) { s0[r_] = EXP2(__builtin_fmaf(s0[r_], SC2, -m)); s1[r_] = EXP2(__builtin_fmaf(s1[r_], SC2, -m)); ps_ += s0[r_] + s1[r_]; } \
        l += ps_; \
        pf[0] = pack8(s0[0], s0[1], s0[2], s0[3], s0[4], s0[5], s0[6], s0[7]); pf[1] = pack8(s0[8], s0[9], s0[10], s0[11], s0[12], s0[13], s0[14], s0[15]); \
        pf[2] = pack8(s1[0], s1[1], s1[2], s1[3], s1[4], s1[5], s1[6], s1[7]); pf[3] = pack8(s1[8], s1[9], s1[10], s1[11], s1[12], s1[13], s1[14], s1[15]); } while (0)
#define PA_PV2(Vb) do { _Pragma("unroll") for (int s_ = 0; s_ < 4; ++s_) { \
            { const bf16x8 vf_ = cat8(trrd((Vb) + vlane + (16 * s_) * VP), trrd((Vb) + vlane + (16 * s_ + 8) * VP)); o0 = __builtin_amdgcn_mfma_f32_32x32x16_bf16(vf_, pfp[s_], o0, 0, 0, 0); } \
            { const bf16x8 vf_ = cat8(trrd((Vb) + vlane + (16 * s_) * VP + 64), trrd((Vb) + vlane + (16 * s_ + 8) * VP + 64)); o1 = __builtin_amdgcn_mfma_f32_32x32x16_bf16(vf_, pfp[s_], o1, 0, 0, 0); } } } while (0)
#define PA_IT(t_, DOQK, DOSM, DOPV, rkS, rvS, rrS, rkL, rvL, rrL) do { const int tt_ = (t_); float al_ = 1.f; bool resc_ = false; \
        PA_LOAD(rkS, rvS, rrS, tt_ + 2, tt_); \
        if (DOQK) { LAS unsigned char* Kn_ = lds + ((tt_ + 1) & 1) * KBUF; PA_QK(Kn_, sB0, sB1); } \
        if ((DOSM) != 0) PA_SM2(tt_, (DOSM) - 1, sA0, sA1, al_, resc_); \
        __builtin_amdgcn_sched_barrier(0); \
        if (DOPV) { LAS unsigned char* Vb_ = lds + OFF_V + ((tt_ - 1) & 1) * VBUF; PA_PV2(Vb_); } \
        if ((DOSM) != 0 && resc_) { _Pragma("unroll") for (int r_ = 0; r_ < 16; ++r_) { o0[r_] *= al_; o1[r_] *= al_; } } \
        if ((DOSM) != 0) { pfp[0] = pf[0]; pfp[1] = pf[1]; pfp[2] = pf[2]; pfp[3] = pf[3]; } \
        if (DOQK) { sA0 = sB0; sA1 = sB1; } \
        PA_STORE(rkS, rvS, rrS, tt_ + 2, tt_); \
        __syncthreads(); } while (0)
    { const v4u rk = *(const v4u*)gkn, rk1 = *(const v4u*)(gkn + (size_t)64 * 1024); v4u rr = (v4u){0u, 0u, 0u, 0u}, rr1 = rr; if (hasr) { rr = *(const v4u*)gkr; rr1 = *(const v4u*)(gkr + (size_t)64 * RD); }
      *(LAS v4u*)(lds + wK) = rk; if (hasr) *(LAS v4u*)(lds + wR) = rr;
      *(LAS v4u*)(lds + KBUF + wK) = rk1; if (hasr) *(LAS v4u*)(lds + KBUF + wR) = rr1; }
    __syncthreads();
    PA_QK(lds, sA0, sA1);
    __syncthreads();
    PA_IT(0, true, 3, false, rkA, rvA, rrA, rkA, rvA, rrA);
    if (qb > 0) {
#pragma unroll 1
        for (int t = 1; t < NT - 5; t += 2) {
            PA_IT(t, true, 1, true, rkA, rvA, rrA, rkA, rvA, rrA);
            PA_IT(t + 1, true, 1, true, rkA, rvA, rrA, rkA, rvA, rrA);
        }
        PA_IT(NT - 5, true, 1, true, rkA, rvA, rrA, rkA, rvA, rrA);
        PA_IT(NT - 4, true, 2, true, rkA, rvA, rrA, rkA, rvA, rrA);
    }
    PA_IT(NT - 3, true, 2, true, rkA, rvA, rrA, rkA, rvA, rrA);
    PA_IT(NT - 2, true, 2, true, rkA, rvA, rrA, rkA, rvA, rrA);
    PA_IT(NT - 1, false, 2, true, rkA, rvA, rrA, rkA, rvA, rrA);
    PA_IT(NT, false, 0, true, rkA, rvA, rrA, rkA, rvA, rrA);
#undef PA_LOAD
#undef PA_STORE
#undef PA_SM2
#undef PA_PV2
#undef PA_IT
#undef PA_QK
#undef PA_SOFTMAX
#undef PA_PV
    l += __shfl_xor(l, 32); const float inv = 1.f / l;
    bf16* op = O + (rowb + qw + r32) * 1024 + h * 64 + 4 * hi;
#pragma unroll
    for (int g4 = 0; g4 < 4; ++g4) { v2u w; w.x = cvtpk(o0[4 * g4] * inv, o0[4 * g4 + 1] * inv); w.y = cvtpk(o0[4 * g4 + 2] * inv, o0[4 * g4 + 3] * inv); *(v2u*)(op + 8 * g4) = w;
        w.x = cvtpk(o1[4 * g4] * inv, o1[4 * g4 + 1] * inv); w.y = cvtpk(o1[4 * g4 + 2] * inv, o1[4 * g4 + 3] * inv); *(v2u*)(op + 32 + 8 * g4) = w; }
}

template <bool NEWK>
__device__ __forceinline__ void dattn_step(LAS unsigned char* Kb, LAS unsigned char* Qw, f32x16 (&o)[8], float& m, float& l, unsigned klane, unsigned vlane, int hi, int stok) {
    constexpr int KP = 592;
    f32x16 p0, p1;
#pragma unroll
    for (int r = 0; r < 16; ++r) { p0[r] = 0.f; p1[r] = 0.f; }
    { bf16x8 fq[2][2], fa[2][2], fb[2][2];
#define DS_LD(set, g_) do { _Pragma("unroll") for (int e_ = 0; e_ < 2; ++e_) { const int ks_ = 2 * (g_) + e_; fq[set][e_] = *(const LAS bf16x8*)(Qw + klane + ks_ * 32); fa[set][e_] = *(const LAS bf16x8*)(Kb + klane + ks_ * 32); \
            if (!NEWK) fb[set][e_] = *(const LAS bf16x8*)(Kb + klane + 32 * KP + ks_ * 32); } } while (0)
#define DS_MM(set) do { _Pragma("unroll") for (int e_ = 0; e_ < 2; ++e_) { p0 = __builtin_amdgcn_mfma_f32_32x32x16_bf16(fa[set][e_], fq[set][e_], p0, 0, 0, 0); \
            if (!NEWK) p1 = __builtin_amdgcn_mfma_f32_32x32x16_bf16(fb[set][e_], fq[set][e_], p1, 0, 0, 0); } } while (0)
      DS_LD(0, 0);
#pragma unroll
      for (int g2 = 0; g2 < 9; g2 += 2) {
          if (g2 + 1 < 9) DS_LD(1, g2 + 1);
          __builtin_amdgcn_sched_barrier(0); DS_MM(0); __builtin_amdgcn_sched_barrier(0);
          if (g2 + 2 < 9) DS_LD(0, g2 + 2);
          __builtin_amdgcn_sched_barrier(0); if (g2 + 1 < 9) DS_MM(1); __builtin_amdgcn_sched_barrier(0);
      }
#undef DS_LD
#undef DS_MM
    }
    if (NEWK) {
#pragma unroll
        for (int r = 0; r < 16; ++r) { const int key = (r & 3) + 8 * (r >> 2) + 4 * hi; if (key > stok) p0[r] = -INFINITY; p1[r] = -INFINITY; } }
    float rm = fmaxf(p0[0], p1[0]);
#pragma unroll
    for (int r = 1; r < 16; ++r) rm = fmaxf(rm, fmaxf(p0[r], p1[r]));
    rm = hmax32(rm) * SC2;
    if (__any(rm > m + RESC_TAU)) { const float mn = fmaxf(m, rm), al = EXP2(m - mn); m = mn; l *= al;
#pragma unroll
        for (int c = 0; c < 8; ++c)
#pragma unroll
            for (int r = 0; r < 16; ++r) o[c][r] *= al; }
    float ps = 0.f;
#pragma unroll
    for (int r = 0; r < 16; ++r) { p0[r] = EXP2(__builtin_fmaf(p0[r], SC2, -m)); p1[r] = EXP2(__builtin_fmaf(p1[r], SC2, -m)); ps += p0[r] + p1[r]; }
    l += ps;
    bf16x8 pf[4];
    pf[0] = pack8(p0[0], p0[1], p0[2], p0[3], p0[4], p0[5], p0[6], p0[7]); pf[1] = pack8(p0[8], p0[9], p0[10], p0[11], p0[12], p0[13], p0[14], p0[15]);
    pf[2] = pack8(p1[0], p1[1], p1[2], p1[3], p1[4], p1[5], p1[6], p1[7]); pf[3] = pack8(p1[8], p1[9], p1[10], p1[11], p1[12], p1[13], p1[14], p1[15]);
    { constexpr int NG = NEWK ? 2 : 8; s16x4 vl[2][4], vh[2][4];
#define DV_LD(set, g_) do { const int s_ = (g_) >> 1, c0_ = 4 * ((g_) & 1); _Pragma("unroll") for (int e_ = 0; e_ < 4; ++e_) { \
            vl[set][e_] = trrd(Kb + vlane + (16 * s_) * KP + (c0_ + e_) * 64); vh[set][e_] = trrd(Kb + vlane + (16 * s_ + 8) * KP + (c0_ + e_) * 64); } } while (0)
#define DV_MM(set, g_) do { const int s_ = (g_) >> 1, c0_ = 4 * ((g_) & 1); _Pragma("unroll") for (int e_ = 0; e_ < 4; ++e_) \
            o[c0_ + e_] = __builtin_amdgcn_mfma_f32_32x32x16_bf16(cat8(vl[set][e_], vh[set][e_]), pf[s_], o[c0_ + e_], 0, 0, 0); } while (0)
      DV_LD(0, 0);
#pragma unroll
      for (int g2 = 0; g2 < NG; g2 += 2) {
          DV_LD(1, g2 + 1);
          __builtin_amdgcn_sched_barrier(0); DV_MM(0, g2); __builtin_amdgcn_sched_barrier(0);
          if (g2 + 2 < NG) DV_LD(0, g2 + 2);
          __builtin_amdgcn_sched_barrier(0); DV_MM(1, g2 + 1); __builtin_amdgcn_sched_barrier(0);
      }
#undef DV_LD
#undef DV_MM
    }
}
__device__ __forceinline__ void dattn_unit(LAS unsigned char* lds, const bf16* QD, const float* ckvc, const float* krc, const int* ptab, const bf16* CKV, const bf16* KRB, float* DPART, float* DML, int unit) {
    const int bd = unit >> 1, half = unit & 1;
    const int tid = opaque_tid(), lane = tid & 63, wid = __builtin_amdgcn_readfirstlane(tid >> 6), r32 = lane & 31, hi = lane >> 5;
    constexpr int KP = 592, KBUF = 64 * KP;
    const bool comp = wid < 4;
    for (int i = tid; i < 128 * 36; i += NWAVES * 64) { const int row = i / 36, ch = i % 36; *(LAS v4u*)(lds + 2 * KBUF + row * KP + ch * 16) = *(const v4u*)(QD + ((size_t)bd * 128 + row) * 288 + ch * 8); }
    const int* pt = ptab + bd * NPAGE;
    const int lt = tid & 255;
    f32x4 preA[18], preB[18];
#define DLOAD(pre, T) do { const int T_ = (T); const size_t rb_ = (size_t)pt[T_ >> 1] * 128 + (size_t)(T_ & 1) * 64; const float* lp_ = ckvc + rb_ * 256; const float* rp_ = krc + rb_ * 32; \
        _Pragma("unroll") for (int i_ = 0; i_ < 16; ++i_) pre[i_] = __builtin_nontemporal_load((const f32x4*)(lp_ + (size_t)(lt + 256 * i_) * 4)); \
        _Pragma("unroll") for (int i_ = 0; i_ < 2; ++i_) pre[16 + i_] = __builtin_nontemporal_load((const f32x4*)(rp_ + (size_t)(lt + 256 * i_) * 4)); } while (0)
#define DSTORE(pre, buf) do { LAS unsigned char* b_ = lds + (buf) * KBUF; \
        _Pragma("unroll") for (int i_ = 0; i_ < 16; ++i_) { const int id_ = lt + 256 * i_; v2u w_; w_.x = cvtpk(pre[i_].x, pre[i_].y); w_.y = cvtpk(pre[i_].z, pre[i_].w); *(LAS v2u*)(b_ + (id_ >> 6) * KP + (id_ & 63) * 8) = w_; } \
        _Pragma("unroll") for (int i_ = 0; i_ < 2; ++i_) { const int id_ = lt + 256 * i_; v2u w_; w_.x = cvtpk(pre[16 + i_].x, pre[16 + i_].y); w_.y = cvtpk(pre[16 + i_].z, pre[16 + i_].w); *(LAS v2u*)(b_ + (id_ >> 3) * KP + 512 + (id_ & 7) * 8) = w_; } } while (0)
    const int T0 = half * 64;
    float m = -INFINITY, l = 0.f; f32x16 o[8];
    const int q4 = (lane & 15) >> 2, p4 = lane & 3, blk = (lane >> 4) & 1;
    const unsigned klane = r32 * KP + hi * 16, vlane = (4 * hi + q4) * KP + (16 * blk + 4 * p4) * 2;
    LAS unsigned char* Qw = lds + 2 * KBUF + (wid & 3) * 32 * KP;
    const int stok = 2 * (wid & 3) + (r32 >> 4);
    if (comp) {
#pragma unroll
        for (int c = 0; c < 8; ++c)
#pragma unroll
            for (int r = 0; r < 16; ++r) o[c][r] = 0.f;
        __syncthreads();
#pragma unroll 1
        for (int j = 0; j < 64; j += 2) {
            dattn_step<false>(lds, Qw, o, m, l, klane, vlane, hi, stok);
            __syncthreads();
            dattn_step<false>(lds + KBUF, Qw, o, m, l, klane, vlane, hi, stok);
            __syncthreads();
        }
    } else {
        DLOAD(preA, T0); DLOAD(preB, T0 + 1); DSTORE(preA, 0); DLOAD(preA, T0 + 2);
        __syncthreads();
#pragma unroll 1
        for (int j = 0; j < 64; j += 2) {
            DSTORE(preB, 1); DLOAD(preB, T0 + (j + 3 < 64 ? j + 3 : 63));
            __syncthreads();
            DSTORE(preA, 0); DLOAD(preA, T0 + (j + 4 < 64 ? j + 4 : 63));
            __syncthreads();
        }
    }
#undef DLOAD
#undef DSTORE
    if (half == 1) {
        for (int i = tid; i < 32 * 36; i += NWAVES * 64) { const int row = i / 36, ch = i % 36; v4u v = (v4u){0u, 0u, 0u, 0u};
            if (row < 8) v = ch < 32 ? *(const v4u*)(CKV + (size_t)(NPR + bd * 8 + row) * KVL + ch * 8) : *(const v4u*)(KRB + (size_t)(NPR + bd * 8 + row) * RD + (ch - 32) * 8);
            *(LAS v4u*)(lds + row * KP + ch * 16) = v; }
        __syncthreads();
        if (comp) dattn_step<true>(lds, Qw, o, m, l, klane, vlane, hi, stok);
        __syncthreads();
    }
    if (comp) {
        l += __shfl_xor(l, 32);
        const int row = (wid & 3) * 32 + r32;
        float* dp = DPART + ((size_t)unit * 128 + row) * 256 + 4 * hi;
#pragma unroll
        for (int c = 0; c < 8; ++c)
#pragma unroll
            for (int g4 = 0; g4 < 4; ++g4) *(f32x4*)(dp + 32 * c + 8 * g4) = (f32x4){o[c][4 * g4], o[c][4 * g4 + 1], o[c][4 * g4 + 2], o[c][4 * g4 + 3]};
        if (hi == 0) { DML[((size_t)unit * 128 + row) * 2] = m; DML[((size_t)unit * 128 + row) * 2 + 1] = l; }
    }
}

__device__ __forceinline__ void ph_attention(const Frame& F, const Args& a) {
    unsigned char* ws = a.ws;
    const bf16* QP = (const bf16*)(ws + WS_QP); const bf16* KN = (const bf16*)(ws + WS_KN); const bf16* KRB = (const bf16*)(ws + WS_KRB); const bf16* VV = (const bf16*)(ws + WS_VV); bf16* O = (bf16*)(ws + WS_O);
#ifndef PROBE_DEC_REP
#define PROBE_DEC_REP 1
#endif
#ifndef PROBE_PRO_REP
#define PROBE_PRO_REP 1
#endif
#ifndef ATT_ORDER
#define ATT_ORDER 2
#endif
#define DEC_UNITS() do { _Pragma("unroll 1") for (int rep_ = 0; rep_ < PROBE_DEC_REP; ++rep_) _Pragma("unroll 1") for (int u = F.vcu; u < 2 * NDB; u += F.G) \
        dattn_unit(F.lds, (const bf16*)(ws + WS_QD), (const float*)a.in[2], (const float*)a.in[3], (const int*)a.in[6], (const bf16*)(ws + WS_CKV), KRB, (float*)(ws + WS_DPART), (float*)(ws + WS_DML), u); } while (0)
#define PRO_UNITS(i0_, i1_) do { _Pragma("unroll 1") for (int rep_ = 0; rep_ < PROBE_PRO_REP; ++rep_) { \
        if (F.G == 256) { const int xq = F.vcu >> 5, jq = F.vcu & 31; \
            _Pragma("unroll 1") for (int i = (i0_); i < (i1_); ++i) { const int bh = 4 * xq + i, qb = (i & 1) ? 31 - jq : jq; pattn_unit(F.lds, QP, KN, KRB, VV, O, bh >> 4, bh & 15, qb); } \
        } else if ((i0_) == 0) { _Pragma("unroll 1") for (int u = F.vcu; u < 1024; u += F.G) pattn_unit(F.lds, QP, KN, KRB, VV, O, u >> 9, (u >> 5) & 15, 31 - (u & 31)); } } } while (0)
#if ATT_ORDER == 2
    const int dpos = F.vcu % 3;
    if (dpos == 0) DEC_UNITS();
    if (F.G == 256) { const int xq = F.vcu >> 5, jq = F.vcu & 31;
#pragma unroll 1
        for (int i = 0; i < 4; ++i) { if (i == 2 && dpos == 1) DEC_UNITS();
            const int bh = 4 * xq + i, qb = (i & 1) ? 31 - jq : jq; pattn_unit(F.lds, QP, KN, KRB, VV, O, bh >> 4, bh & 15, qb); }
    } else { if (dpos == 1) DEC_UNITS(); PRO_UNITS(0, 4); }
    if (dpos == 2) DEC_UNITS();
#else
    const bool dec_first = ATT_ORDER ? (F.vcu & 1) : true;
    if (dec_first) DEC_UNITS();
    PRO_UNITS(0, 4);
    if (!dec_first) DEC_UNITS();
#endif
#undef DEC_UNITS
#undef PRO_UNITS
}

__device__ __forceinline__ void ph_dcombine(const Frame& F, const Args& a) {
    unsigned char* ws = a.ws;
    const float* DPART = (const float*)(ws + WS_DPART); const float* DML = (const float*)(ws + WS_DML); const float* wuv = (const float*)a.in[21]; bf16* O = (bf16*)(ws + WS_O);
    LAS float* olat = (LAS float*)F.lds;
    const int lane = F.lane, w = F.wave;
    for (int un = F.vcu; un < 2 * NDB; un += F.G) { const int bd = un >> 1, hh = un & 1;
#pragma unroll 4
        for (int h8 = 0; h8 < 8; ++h8) { const int r = w * 16 + 8 * hh + h8;
            const size_t u0 = (size_t)(bd * 2) * 128 + r, u1 = (size_t)(bd * 2 + 1) * 128 + r;
            const f32x2 ml0 = *(const f32x2*)(DML + u0 * 2), ml1 = *(const f32x2*)(DML + u1 * 2);
            const float M = fmaxf(ml0.x, ml1.x), w0 = EXP2(ml0.x - M), w1 = EXP2(ml1.x - M), L = ml0.y * w0 + ml1.y * w1;
            const f32x4 acc = *(const f32x4*)(DPART + u0 * 256 + 4 * lane) * w0 + *(const f32x4*)(DPART + u1 * 256 + 4 * lane) * w1;
            *(LAS f32x4*)(olat + (h8 * 8 + w) * 256 + ((4 * lane) ^ (4 * (h8 & 3)))) = acc * (1.f / L);
        }
        __syncthreads();
        { const int qd = w & 1, kq = w >> 1, hl = lane >> 4, h8 = 4 * qd + hl, h = 8 * hh + h8, v0 = 4 * (lane & 15), sw = 4 * hl;
          f32x4 acc[8];
#pragma unroll
          for (int s = 0; s < 8; ++s) acc[s] = (f32x4){0.f, 0.f, 0.f, 0.f};
          const float* wp = wuv + (size_t)(64 * kq) * 1024 + 256 * (2 * hh + qd) + 4 * lane; const LAS float* ob = olat + (h8 * 8) * 256;
#pragma unroll 4
          for (int kk = 0; kk < 16; ++kk) { const int k = 64 * kq + 4 * kk;
              const f32x4 w0 = *(const f32x4*)(wp + (size_t)(4 * kk) * 1024), w1 = *(const f32x4*)(wp + (size_t)(4 * kk + 1) * 1024), w2 = *(const f32x4*)(wp + (size_t)(4 * kk + 2) * 1024), w3 = *(const f32x4*)(wp + (size_t)(4 * kk + 3) * 1024);
#pragma unroll
              for (int s = 0; s < 8; ++s) { const f32x4 o = *(const LAS f32x4*)(ob + s * 256 + (k ^ sw)); acc[s] = acc[s] + w0 * o.x + w1 * o.y + w2 * o.z + w3 * o.w; } }
          __syncthreads();
          if (kq > 0) { LAS f32x4* xs = (LAS f32x4*)F.lds + (((kq - 1) * 2 + qd) * 64 + lane) * 8;
#pragma unroll
              for (int s = 0; s < 8; ++s) xs[s] = acc[s]; }
          __syncthreads();
          if (kq == 0) {
#pragma unroll
              for (int s = 0; s < 8; ++s) { f32x4 t = acc[s];
#pragma unroll
                  for (int q = 0; q < 3; ++q) t = t + ((const LAS f32x4*)F.lds)[((q * 2 + qd) * 64 + lane) * 8 + s];
                  v2u o; o.x = pk2(t.x, t.y); o.y = pk2(t.z, t.w); *(v2u*)(O + (size_t)(NPR + bd * 8 + s) * 1024 + h * 64 + v0) = o; } }
          __syncthreads();
        }
    }
}

__device__ __forceinline__ void ph_conv(const Frame& F, const Args& a, int L) {
    unsigned char* ws = a.ws; const bf16* U = (const bf16*)(ws + WS_U); bf16* A2 = (bf16*)(ws + WS_A2);
    const float* cw = (const float*)a.in[26] + (size_t)L * 3 * FF2; const float* cb = (const float*)a.in[27] + (size_t)L * FF2; const float* stc = (const float*)a.in[5] + (size_t)L * NDB * 2 * FF2;
    const int tid = F.tid;
    if (tid >= 352) return;
    const int c = 8 * tid, NI = NR / 8;
    f32x4 wgt[2][4][2];
#pragma unroll
    for (int p = 0; p < 2; ++p)
#pragma unroll
        for (int k = 0; k < 4; ++k) { const float* src = (k < 3 ? cw + (size_t)k * FF2 : cb) + p * FF + c; wgt[p][k][0] = *(const f32x4*)src; wgt[p][k][1] = *(const f32x4*)(src + 4); }
    const int ilast = F.vcu + ((NI - 1 - F.vcu) / F.G) * F.G;
#define CV_ROWPTR(item_, p_, i_) (U + (size_t)(((item_) < ilast ? (item_) : ilast) * 8 + (((i_) < 2 && ((((item_) < ilast ? (item_) : ilast) * 8 >= NPR) || (((((item_) < ilast ? (item_) : ilast) * 8) & 8191) == 0))) ? 0 : (i_) - 2)) * FF2 + (p_) * FF + c)
#define CV_UNPACK(dst, v) do { dst[0] = bflo((v).x); dst[1] = bfhi((v).x); dst[2] = bflo((v).y); dst[3] = bfhi((v).y); dst[4] = bflo((v).z); dst[5] = bfhi((v).z); dst[6] = bflo((v).w); dst[7] = bfhi((v).w); } while (0)
    v4u raw[2][10];
#pragma unroll
    for (int i = 0; i < 2; ++i)
#pragma unroll
        for (int p = 0; p < 2; ++p) raw[p][i] = *(const v4u*)CV_ROWPTR(F.vcu, p, i);
#pragma unroll
    for (int i = 2; i < 10; ++i)
#pragma unroll
        for (int p = 0; p < 2; ++p) raw[p][i] = *(const v4u*)CV_ROWPTR(F.vcu, p, i);
#pragma unroll 1
    for (int item = F.vcu; item < NI; item += F.G) {
        const int nxt = item + F.G;
        const int row0 = item * 8; const bool smp = row0 >= NPR; const int bd = (row0 - NPR) >> 3, t0 = row0 & 8191;
        float um2[2][8], um1[2][8];
#pragma unroll
        for (int i = 0; i < 2; ++i)
#pragma unroll
            for (int p = 0; p < 2; ++p) { if (i == 0) CV_UNPACK(um2[p], raw[p][0]); else CV_UNPACK(um1[p], raw[p][1]); raw[p][i] = *(const v4u*)CV_ROWPTR(nxt, p, i); }
#pragma unroll
        for (int p = 0; p < 2; ++p) {
            if (smp) { const float* s0 = stc + ((size_t)bd * 2) * FF2 + p * FF + c;
#pragma unroll
                for (int e = 0; e < 8; ++e) { um2[p][e] = s0[e]; um1[p][e] = s0[FF2 + e]; } }
            else if (t0 == 0) {
#pragma unroll
                for (int e = 0; e < 8; ++e) { um2[p][e] = 0.f; um1[p][e] = 0.f; } } }
#pragma unroll
        for (int t = 0; t < 8; ++t) { float cv[2][8];
#pragma unroll
            for (int p = 0; p < 2; ++p) { float u0[8]; CV_UNPACK(u0, raw[p][t + 2]); raw[p][t + 2] = *(const v4u*)CV_ROWPTR(nxt, p, t + 2);
#pragma unroll
                for (int h4 = 0; h4 < 2; ++h4) { const f32x4 k0 = wgt[p][0][h4], k1 = wgt[p][1][h4], k2 = wgt[p][2][h4], kb = wgt[p][3][h4];
#pragma unroll
                    for (int e4 = 0; e4 < 4; ++e4) { const int e = 4 * h4 + e4; cv[p][e] = kb[e4] + um2[p][e] * k0[e4] + um1[p][e] * k1[e4] + u0[e] * k2[e4]; um2[p][e] = um1[p][e]; um1[p][e] = u0[e]; } } }
            float g[8];
#pragma unroll
            for (int e = 0; e < 8; ++e) { const float x = cv[0][e]; g[e] = x * __builtin_amdgcn_rcpf(1.f + __builtin_amdgcn_exp2f(x * -1.4426950408889634f)) * cv[1][e]; }
            v4u o; o.x = cvtpk(g[0], g[1]); o.y = cvtpk(g[2], g[3]); o.z = cvtpk(g[4], g[5]); o.w = cvtpk(g[6], g[7]);
            *(v4u*)(A2 + (size_t)(row0 + t) * FF + c) = o; }
        if (smp || t0 == 8184) { float* so = smp ? a.out + OUT_CSS + ((size_t)(L * NDB + bd) * 2) * FF2 : a.out + OUT_CSP + ((size_t)(L * 2 + (row0 >> 13)) * 2) * FF2;
#pragma unroll
            for (int p = 0; p < 2; ++p)
#pragma unroll
                for (int e = 0; e < 8; ++e) { so[p * FF + c + e] = um2[p][e]; so[FF2 + p * FF + c + e] = um1[p][e]; } }
    }
#undef CV_ROWPTR
#undef CV_UNPACK
}

__device__ __forceinline__ void ph_pool(const Frame& F, const Args& a) {
    unsigned char* ws = a.ws; const bf16* H1 = (const bf16*)(ws + WS_H1); bf16* PO = (bf16*)(ws + WS_POOLED); const float* stp = (const float*)a.in[4];
    const int tid = F.tid, sub = tid >> 7, cg = tid & 127, d = 8 * cg, wdw = 2 << (cg >> 5);
#pragma unroll 1
    for (int item = 4 * F.vcu + sub; item < NR / 8; item += 4 * F.G) {
        const int row0 = item * 8; const bool smp = row0 >= NPR; const int bd = (row0 - NPR) >> 3, t0 = row0 & 8191;
        v4u r[23];
#pragma unroll
        for (int i = 0; i < 23; ++i) { const int tt = i - 15; r[i] = (v4u){0u, 0u, 0u, 0u};
            if (tt > -wdw) { if (smp && tt < 0) { const float* sp = stp + ((size_t)bd * 15 + 15 + tt) * DM + d; const f32x4 s0 = *(const f32x4*)sp, s1 = *(const f32x4*)(sp + 4);
                                 r[i].x = pk2(s0.x, s0.y); r[i].y = pk2(s0.z, s0.w); r[i].z = pk2(s1.x, s1.y); r[i].w = pk2(s1.z, s1.w); }
                             else if (smp || t0 + tt >= 0) r[i] = *(const v4u*)(H1 + (size_t)(row0 + tt) * DM + d); } }
        float sum[8];
#pragma unroll
        for (int e = 0; e < 8; ++e) sum[e] = 0.f;
#define PL_ACC(v, sgn) do { sum[0] += (sgn) * bflo((v).x); sum[1] += (sgn) * bfhi((v).x); sum[2] += (sgn) * bflo((v).y); sum[3] += (sgn) * bfhi((v).y); \
        sum[4] += (sgn) * bflo((v).z); sum[5] += (sgn) * bfhi((v).z); sum[6] += (sgn) * bflo((v).w); sum[7] += (sgn) * bfhi((v).w); } while (0)
#pragma unroll
        for (int i = 0; i < 15; ++i) if (i - 15 > -wdw) PL_ACC(r[i], 1.f);
#pragma unroll
        for (int t = 0; t < 8; ++t) { const v4u cur = r[15 + t]; PL_ACC(cur, 1.f);
            const int pc = t0 + t + 1; const float ic = 1.f / (smp ? (float)wdw : (float)(pc < wdw ? pc : wdw));
            v4u o; o.x = pk2(sum[0] * ic - bflo(cur.x), sum[1] * ic - bfhi(cur.x)); o.y = pk2(sum[2] * ic - bflo(cur.y), sum[3] * ic - bfhi(cur.y));
            o.z = pk2(sum[4] * ic - bflo(cur.z), sum[5] * ic - bfhi(cur.z)); o.w = pk2(sum[6] * ic - bflo(cur.w), sum[7] * ic - bfhi(cur.w));
            *(v4u*)(PO + (size_t)(row0 + t) * DM + d) = o;
            const v4u old = wdw == 2 ? r[14 + t] : wdw == 4 ? r[12 + t] : wdw == 8 ? r[8 + t] : r[t];
            PL_ACC(old, -1.f); }
#undef PL_ACC
    }
    const int gw = F.vcu * NWAVES + F.wave, NGW = F.G * NWAVES, lane = F.lane;
    for (int i = gw; i < NDB * 7; i += NGW) { const int bd = i / 7, k = i % 7; const float* src = stp + ((size_t)bd * 15 + 8 + k) * DM; float* dst = a.out + OUT_PSS + ((size_t)bd * 15 + k) * DM;
#pragma unroll
        for (int j = 0; j < 4; ++j) *(f32x4*)(dst + 4 * lane + 256 * j) = *(const f32x4*)(src + 4 * lane + 256 * j);
    }
}

constexpr int NPHASES = 22;
#ifndef PROBE_GEMM_REP
#define PROBE_GEMM_REP 1
#endif
#ifndef PROBE_THIN_REP
#define PROBE_THIN_REP 1
#endif
#ifndef PROBE_THIN_MASK
#define PROBE_THIN_MASK 0
#endif
#define TREPK(k) _Pragma("unroll 1") for (int rep_ = 0; rep_ < (((PROBE_THIN_MASK >> (k)) & 1) ? 2 : 1); ++rep_)
#ifndef MK_PER_PHASE
#define MK_PER_PHASE 0
#endif

#define PROJ1024(Aptr, lda_, Btptr, Ktot, S_, Optr) do { \
        pg8::Gemm gh{(const pg8::bf16_t*)(Aptr), (const pg8::bf16_t*)(Btptr), NR, 1024, (Ktot) / (S_), (lda_), 0, (Ktot)}; pg8::HybridOrder<S_> Sh; Sh.init(NPR, 1024, (Ktot), F.G, (int)blockIdx.x); \
        pg8::EpiHybrid Eh{(pg8::bf16_t*)(Optr), 1024, (float*)(ws + WS_TMPS), (size_t)NSR * 1024}; \
        pg8::gemm_phase<pg8::EpiHybrid, pg8::HybridOrder<S_>, true, true>(F.lds, gh, Sh, Eh); } while (0)

#define AS4 __attribute__((address_space(4)))
__device__ __forceinline__ Args fresh_args() {
    const Args AS4* ap = (const Args AS4*)__builtin_amdgcn_kernarg_segment_ptr();
    asm volatile("" : "+s"(ap));
    Args a;
#pragma unroll
    for (int i = 0; i < 29; ++i) a.in[i] = ap->in[i];
    a.out = ap->out; a.ws = ap->ws; a.ph_lo = ap->ph_lo; a.ph_hi = ap->ph_hi;
    return a;
}
#define PHASE_ARGS const Args args = fresh_args(); unsigned char* const ws = args.ws; float* const out = args.out; float* const MOD = (float*)(ws + WS_MOD); float* const TMP = (float*)(ws + WS_TMP); \
    bf16* const TMPb = (bf16*)(ws + WS_TMP); bf16* const HN = (bf16*)(ws + WS_HN); (void)out; (void)MOD; (void)TMP; (void)TMPb; (void)HN

__device__ __forceinline__ bool fresh(Frame& F) { const int t = opaque_tid(); F.tid = t; F.lane = t & 63; return true; }

__device__ __forceinline__ void ffn_gemms(Frame& F, int L, int pbase, int lo, int hi, const XcdBarrier& bar) {
#define IN(k) ((lo <= (k) && (k) < hi) && fresh(F))
#ifdef PROBE_BAR2
#define SEAM(k) do { if ((lo <= (k) && (k) < hi) && (lo <= (k) + 1 && (k) + 1 < hi)) { xcd_barrier(bar); xcd_barrier(bar); } } while (0)
#else
#define SEAM(k) do { if ((lo <= (k) && (k) < hi) && (lo <= (k) + 1 && (k) + 1 < hi)) xcd_barrier(bar); } while (0)
#endif
    if (IN(pbase)) { PHASE_ARGS;
        pg8::Gemm g{(const pg8::bf16_t*)(ws + WS_HN), (const pg8::bf16_t*)(ws + WS_WUP) + (size_t)L * FF2 * 1024, NR, FF2, 1024, 1024, 0, 1024}; pg8::StaticOrder S; S.init(NR, FF2, F.G, (int)blockIdx.x);
        pg8::EpiBf16<0> E{(pg8::bf16_t*)(ws + WS_U), FF2, nullptr, 0, 0, 1.f};
        pg8::gemm_phase<pg8::EpiBf16<0>, pg8::StaticOrder, true, true>(F.lds, g, S, E);
#ifdef PROBE_UP2
        pg8::gemm_phase<pg8::EpiBf16<0>, pg8::StaticOrder, true, true>(F.lds, g, S, E);
#endif
    }
    SEAM(pbase);
    if (IN(pbase + 1)) { PHASE_ARGS; TREPK(5) ph_conv(F, args, L); }
    SEAM(pbase + 1);
    if (IN(pbase + 2)) { PHASE_ARGS;
        PROJ1024(ws + WS_A2, FF, (const pg8::bf16_t*)(ws + WS_WDOWN) + (size_t)L * 1024 * FF, FF, 11, ws + WS_TMP);
    }
    SEAM(pbase + 2);
#undef IN
#undef SEAM
}

__global__ void __launch_bounds__(NWAVES * 64, 2) fwd(Args args_in_kernarg) {
    extern __shared__ __attribute__((aligned(16))) unsigned char lds[];
    Frame F;
    F.lds = (LAS unsigned char*)lds; F.MISC = (volatile LAS unsigned*)(F.lds + MISC_OFF);
    F.tid = threadIdx.x; F.lane = F.tid & 63; F.wave = __builtin_amdgcn_readfirstlane(F.tid >> 6);
    F.G = gridDim.x; { const int bx = blockIdx.x; F.vcu = (F.G % 8 == 0) ? (bx % 8) * (F.G / 8) + bx / 8 : bx; }
    int lo, hi; { const Args a0 = fresh_args(); F.ctl = (gu32*)(a0.ws + WS_CTL); lo = a0.ph_lo; hi = a0.ph_hi; }
    for (int u = F.tid; u < (LDS_BYTES - LDSCTL_OFF) / 4; u += NWAVES * 64) ((LAS unsigned*)(F.lds + LDSCTL_OFF))[u] = 0u;
    __syncthreads();
    XcdBarrier bar; bar.bar = (unsigned*)(F.ctl + CW_BAR); bar.x = 0; bar.st = nullptr;
    if (hi - lo > 1) bar = xcd_barrier_post((unsigned*)(F.ctl + CW_BAR), F.MISC + 8);
#define IN(k) ((lo <= (k) && (k) < hi) && fresh(F))
#ifdef PROBE_BAR2
#define SEAM(k) do { if ((lo <= (k) && (k) < hi) && (lo <= (k) + 1 && (k) + 1 < hi)) { xcd_barrier(bar); xcd_barrier(bar); } } while (0)
#else
#define SEAM(k) do { if ((lo <= (k) && (k) < hi) && (lo <= (k) + 1 && (k) + 1 < hi)) xcd_barrier(bar); } while (0)
#endif

    const bool defer = F.G >= 96;
    if (IN(0)) { PHASE_ARGS; ph_prologue<0>(F, args, F.vcu * NWAVES + F.wave, F.G * NWAVES); if (!defer) ph_prologue<1>(F, args, F.vcu * NWAVES + F.wave, F.G * NWAVES); }
    SEAM(0);
    if (IN(1)) { PHASE_ARGS;
        pg8::Gemm g{(const pg8::bf16_t*)(ws + WS_SILUC), (const pg8::bf16_t*)(ws + WS_ADAT), 256, 12288, 1024, 1024, 0, 1024}; pg8::StaticOrder S; S.init(256, 12288, F.G, (int)blockIdx.x);
        pg8::EpiF32 E{MOD, 12288, (const float*)args.in[10], nullptr, 0};
        pg8::gemm_phase<pg8::EpiF32, pg8::StaticOrder, true, true>(F.lds, g, S, E);
        if (defer && (int)blockIdx.x >= 48) ph_prologue<1>(F, args, ((int)blockIdx.x - 48) * NWAVES + F.wave, (F.G - 48) * NWAVES);
    }
    SEAM(1);
    if (IN(2)) { PHASE_ARGS; TREPK(1) ph_rowop<false, 1>(F, (const float*)args.in[0], (const float*)args.in[1], nullptr, nullptr, MOD, nullptr, 0, nullptr, 0 * 1024, 1 * 1024, (const float*)args.in[11], HN, nullptr); }
    SEAM(2);
    if (IN(3)) { PHASE_ARGS;
        PROJ1024(HN, 1024, ws + WS_WDQKV, 1024, 4, TMPb);
    }
    SEAM(3);
    if (IN(4)) { PHASE_ARGS; TREPK(2) ph_qkvpost(F, args); }
    SEAM(4);
    if (IN(5)) { PHASE_ARGS;
        pg8::Gemm g{(const pg8::bf16_t*)(ws + WS_CQ), (const pg8::bf16_t*)(ws + WS_WUQ), NR, 1536, QL, QL, 0, QL}; pg8::StaticOrder S; S.init(NR, 1536, F.G, (int)blockIdx.x);
        pg8::EpiQRope E{(pg8::bf16_t*)(ws + WS_QP), (const float*)(ws + WS_COS), (const float*)(ws + WS_SIN), (pg8::bf16_t*)(ws + WS_QD)};
        pg8::gemm_phase<pg8::EpiQRope, pg8::StaticOrder, true, true>(F.lds, g, S, E);
        pg8::Gemm g2{(const pg8::bf16_t*)(ws + WS_CQ) + (size_t)NPR * QL, (const pg8::bf16_t*)(ws + WS_WABS), NSR, 4096, QL, QL, 0, QL}; pg8::StaticOrder S2; S2.init(NSR, 4096, F.G, F.G - 1 - (int)blockIdx.x);
        pg8::EpiQD E2{(pg8::bf16_t*)(ws + WS_QD)};
        pg8::gemm_phase<pg8::EpiQD, pg8::StaticOrder, true, true>(F.lds, g2, S2, E2);
    }
    if (IN(6)) { PHASE_ARGS;
        pg8::Gemm g{(const pg8::bf16_t*)(ws + WS_CKV), (const pg8::bf16_t*)(ws + WS_WKVUP), NPR, 2048, KVL, KVL, 0, KVL}; pg8::StaticOrder S; S.init(NPR, 2048, F.G, (int)blockIdx.x);
        pg8::EpiBf16<0> E{(pg8::bf16_t*)(ws + WS_KN), 1024, nullptr, 1024, (size_t)(WS_VV - WS_KN) / 2, 1.f};
        pg8::gemm_phase<pg8::EpiBf16<0>, pg8::StaticOrder, true, true>(F.lds, g, S, E);
    }
    SEAM(6);
    if (IN(7)) { PHASE_ARGS; ph_attention(F, args); }
    SEAM(7);
    if (IN(8)) { PHASE_ARGS; TREPK(4) ph_dcombine(F, args); }
    SEAM(8);
    if (IN(9)) { PHASE_ARGS;
        PROJ1024(ws + WS_O, 1024, ws + WS_WO, 1024, 4, TMPb);
    }
    SEAM(9);
    if (IN(10)) { PHASE_ARGS; TREPK(1) ph_rowop<true, 1>(F, (const float*)args.in[0], (const float*)args.in[1], out, TMPb, MOD, nullptr, 2 * 1024, (const float*)args.in[12], 3 * 1024, 4 * 1024, (const float*)args.in[13], HN, nullptr, (const float*)(ws + WS_TMPS), 4, nullptr, (bf16*)(ws + WS_XB)); }
    SEAM(10);
    ffn_gemms(F, 0, 11, lo, hi, bar);
    if (IN(14)) { PHASE_ARGS; ph_rowop<true, 2>(F, out, out + (size_t)NPR * DM, out, TMPb, MOD, nullptr, 5 * 1024, (const float*)args.in[14], 6144 + 0 * 1024, 6144 + 1 * 1024, (const float*)args.in[11] + DM, (bf16*)(ws + WS_H1), out, (const float*)(ws + WS_TMPS), 11, (const bf16*)(ws + WS_XB), (bf16*)(ws + WS_XB)); }
    SEAM(14);
    if (IN(15)) { PHASE_ARGS; TREPK(6) ph_pool(F, args); }
    SEAM(15);
    if (IN(16)) { PHASE_ARGS;
        pg8::Gemm g{(const pg8::bf16_t*)(ws + WS_POOLED), (const pg8::bf16_t*)(ws + WS_POOLT), NR, 1024, 256, 1024, 256, 256}; pg8::StaticOrder S; S.init(NR, 1024, F.G, (int)blockIdx.x);
        pg8::EpiBf16<0> E{(pg8::bf16_t*)TMPb, 1024, nullptr, 0, 0, 1.f};
        pg8::gemm_phase<pg8::EpiBf16<0>, pg8::StaticOrder, true, true>(F.lds, g, S, E);
    }
    SEAM(16);
    if (IN(17)) { PHASE_ARGS; ph_rowop<true, 1>(F, out, out + (size_t)NPR * DM, out, TMPb, MOD, (const float*)args.in[24], 6144 + 2 * 1024, (const float*)args.in[12] + DM, 6144 + 3 * 1024, 6144 + 4 * 1024, (const float*)args.in[13] + DM, HN, nullptr, nullptr, 0, (const bf16*)(ws + WS_XB), (bf16*)(ws + WS_XB)); }
    SEAM(17);
    ffn_gemms(F, 1, 18, lo, hi, bar);
    if (IN(21)) { PHASE_ARGS; ph_rowop<true, 0>(F, out, out + (size_t)NPR * DM, out, TMPb, MOD, nullptr, 6144 + 5 * 1024, (const float*)args.in[14] + DM, 0, 0, nullptr, nullptr, nullptr, (const float*)(ws + WS_TMPS), 11, (const bf16*)(ws + WS_XB), nullptr); }
#undef IN
#undef SEAM
}

extern "C" void kernel_launch(void* const* d_in, const int* in_sizes, int n_in, void* d_out, int out_size, void* d_ws, size_t ws_size, hipStream_t stream) {
    static int grid = 0;
    if (grid == 0) {
        if (n_in != 29 || (size_t)out_size != OUT_TOTAL || ws_size < WS_END) { fprintf(stderr, "kernel_launch: unexpected shapes (n_in %d, out %d, ws %zu); nothing launched\n", n_in, out_size, ws_size); grid = -1; return; }
        int dev = 0, cus = 0, per_cu = 0;
        if (hipGetDevice(&dev) != hipSuccess || hipDeviceGetAttribute(&cus, hipDeviceAttributeMultiprocessorCount, dev) != hipSuccess) { grid = -1; return; }
        if (hipFuncSetAttribute((const void*)fwd, hipFuncAttributeMaxDynamicSharedMemorySize, LDS_BYTES) != hipSuccess) { fprintf(stderr, "kernel_launch: hipFuncSetAttribute failed\n"); grid = -1; return; }
        if (hipOccupancyMaxActiveBlocksPerMultiprocessor(&per_cu, (const void*)fwd, NWAVES * 64, LDS_BYTES) != hipSuccess || per_cu < 1) { fprintf(stderr, "kernel_launch: occupancy query reports %d workgroups per CU\n", per_cu); }
        (void)hipGetLastError();
        if (cus < 176) { fprintf(stderr, "kernel_launch: needs >= 176 CUs\n"); grid = -1; return; }
        grid = cus;
    }
    if (grid < 0) return;
    if (hipMemsetAsync((char*)d_ws + WS_CTL, 0, CTL_ZERO_BYTES, stream) != hipSuccess) return;
    Args a{};
    for (int i = 0; i < 29; ++i) a.in[i] = d_in[i];
    a.out = (float*)d_out; a.ws = (unsigned char*)d_ws;
#if MK_PER_PHASE
    for (int k = 0; k < NPHASES; ++k) { a.ph_lo = k; a.ph_hi = k + 1; hipLaunchKernelGGL(fwd, dim3(grid), dim3(NWAVES * 64), LDS_BYTES, stream, a);
#ifdef PROBE_PHASE_TWICE
        if (k == PROBE_PHASE_TWICE) hipLaunchKernelGGL(fwd, dim3(grid), dim3(NWAVES * 64), LDS_BYTES, stream, a);
#endif
    }
#else
    a.ph_lo = 0; a.ph_hi = NPHASES; hipLaunchKernelGGL(fwd, dim3(grid), dim3(NWAVES * 64), LDS_BYTES, stream, a);
#endif
}
```

```cpp
#include <hip/hip_runtime.h>
#include <cstdio>
#include <cstdint>
#include <cmath>
__device__ __forceinline__ int opaque_tid() { int t = threadIdx.x; asm volatile("" : "+v"(t)); return t; }
namespace pg8 {
#define PG8_LAS __attribute__((address_space(3)))
typedef unsigned short bf16_t;
typedef short bf16x8 __attribute__((ext_vector_type(8)));
typedef float f32x4 __attribute__((ext_vector_type(4)));
typedef unsigned u32x4 __attribute__((ext_vector_type(4)));
constexpr int BM = 256, BK = 64, HALF = 128, HTB = HALF * BK * 2  , STAGE_BYTES = 8 * HTB, NXCD = 8, WGM = 8;

__host__ __device__ __forceinline__ int lds_byte(int r, int c) { const int st = (r >> 4) * 2 + (c >> 5), rr = r & 15, cc = c & 31, ob = rr * 64 + cc * 2; return st * 1024 + (ob ^ (((ob >> 9) & 1) << 5)); }
__host__ __device__ __forceinline__ void stage_rc(int b, int& R, int& C) { const int st = b / 1024, sb = b % 1024, swz = sb ^ (((sb >> 9) & 1) << 5); R = (st >> 1) * 16 + swz / 64; C = (st & 1) * 32 + (swz % 64) / 2; }
__host__ __device__ __forceinline__ int perm32(int rho) { const int n = rho >> 4, i = rho & 15; return 8 * (i >> 2) + 4 * n + (i & 3); }

struct Unit { int pm, pn, pk, nt; };
struct Gemm { const bf16_t* A; const bf16_t* Bt; int M, N, K; int lda, agroup, ldb; };

struct StaticOrder {
    int nM, nN, nwg, G, c;
    __host__ __device__ void init(int M, int N, int G_, int c_) { nM = M / BM; nN = N / BM; nwg = nM * nN; G = G_; c = c_; }
    __host__ __device__ bool next(int i, Unit& u) const {
        const long L = (long)i * G + c; if (L >= nwg) return false;
        int wgid = (int)L; { const int q = nwg / NXCD, r = nwg % NXCD, xcd = wgid % NXCD, off = wgid / NXCD; wgid = (xcd < r ? xcd * (q + 1) : r * (q + 1) + (xcd - r) * q) + off; }
        const int nig = WGM * nN, gid = wgid / nig, fm = gid * WGM, gsz = (nM - fm) < WGM ? (nM - fm) : WGM;
        u.pm = fm + ((wgid % nig) % gsz); u.pn = (wgid % nig) / gsz; u.pk = 0; u.nt = 0; return true;
    }
    __device__ __forceinline__ void a_ready(const Unit&) const {}
    __device__ __forceinline__ void done(const Unit&) const {}
};

typedef float f32x2c __attribute__((ext_vector_type(2))); typedef __bf16 bf16x2c __attribute__((ext_vector_type(2)));
__device__ __forceinline__ unsigned cvt_pk_bf16(float lo, float hi) { const f32x2c v = {lo, hi}; const bf16x2c b = __builtin_convertvector(v, bf16x2c); return __builtin_bit_cast(unsigned, b); }
typedef float f32x2 __attribute__((ext_vector_type(2)));
__device__ __forceinline__ f32x2 gelu_pk(f32x2 v) {
    const f32x2 av = __builtin_elementwise_abs(v), d = av * 0.2316418882f + 1.0f;
    f32x2 t; t.x = __builtin_amdgcn_rcpf(d.x); t.y = __builtin_amdgcn_rcpf(d.y);
    f32x2 q = t * 0.5307027145f + (-0.7265760135f); q = q * t + 0.7107068705f; q = q * t + (-0.142248368f); q = q * t + 0.127414796f; q = q * t;
    const f32x2 s = (v * v) * (-0.72134752044f);
    f32x2 e; e.x = __builtin_amdgcn_exp2f(s.x); e.y = __builtin_amdgcn_exp2f(s.y);
    const f32x2 m = v * (q * e), r = v - m;
    f32x2 o; o.x = v.x < 0.f ? m.x : r.x; o.y = v.y < 0.f ? m.y : r.y; return o;
}

template <int ACT  > struct EpiBf16 {
    static constexpr bool PERM = true, AFTER_DRAIN = false; static_assert(ACT == 0 || ACT == 1, "EpiBf16: ACT is 0 (none) or 1 (gelu_pk)");
    bf16_t* O; int ldc; const float* bias; int split_cols; size_t split_stride; float scale0;
    __device__ __forceinline__ void operator()(const f32x4 (&acc)[2][2][4][2], const Unit& u, int wr, int wc, int fr, int fq) const {
        const int row0 = u.pm * BM + wr * 64 + fr; int colt = u.pn * BM; bf16_t* base = O;
        float sc = 1.f; if (split_cols) { const int t = colt / split_cols; base += (size_t)t * split_stride; colt -= t * split_cols; if (t == 0) sc = scale0; }
        const int col0 = colt + wc * 32 + 8 * fq, bcol0 = u.pn * BM + wc * 32 + 8 * fq;
        f32x4 bv[2][2];
#pragma unroll
        for (int bj = 0; bj < 2; ++bj)
#pragma unroll
            for (int n = 0; n < 2; ++n) bv[bj][n] = bias ? *(const f32x4*)(bias + bcol0 + bj * HALF + 4 * n) : (f32x4){0.f, 0.f, 0.f, 0.f};
#pragma unroll
        for (int ai = 0; ai < 2; ++ai)
#pragma unroll
            for (int m = 0; m < 4; ++m) { bf16_t* rowp = base + (size_t)(row0 + ai * HALF + m * 16) * ldc + col0;
#pragma unroll
                for (int bj = 0; bj < 2; ++bj) { f32x4 v0 = acc[ai][bj][m][0] + bv[bj][0], v1 = acc[ai][bj][m][1] + bv[bj][1];
                    if (ACT == 1) { f32x2 a = gelu_pk((f32x2){v0[0], v0[1]}), b = gelu_pk((f32x2){v0[2], v0[3]}), c = gelu_pk((f32x2){v1[0], v1[1]}), d = gelu_pk((f32x2){v1[2], v1[3]});
                        v0 = (f32x4){a.x, a.y, b.x, b.y}; v1 = (f32x4){c.x, c.y, d.x, d.y}; }
                    v0 = v0 * sc; v1 = v1 * sc; u32x4 w; w.x = cvt_pk_bf16(v0[0], v0[1]); w.y = cvt_pk_bf16(v0[2], v0[3]); w.z = cvt_pk_bf16(v1[0], v1[1]); w.w = cvt_pk_bf16(v1[2], v1[3]);
                    *(u32x4*)(rowp + bj * HALF) = w; } }
    }
};

struct EpiF32 {
    static constexpr bool PERM = false, AFTER_DRAIN = false;
    float* C; int ldc; const float* bias; const float* cscale; size_t kslab;
    __device__ __forceinline__ void operator()(const f32x4 (&acc)[2][2][4][2], const Unit& u, int wr, int wc, int fr, int fq) const {
        const int row0 = u.pm * BM + wr * 64 + fr, col0 = u.pn * BM + wc * 32 + 4 * fq;
        f32x4 bv[2][2], sv[2][2];
#pragma unroll
        for (int bj = 0; bj < 2; ++bj)
#pragma unroll
            for (int n = 0; n < 2; ++n) { bv[bj][n] = bias ? *(const f32x4*)(bias + col0 + bj * HALF + n * 16) : (f32x4){0.f, 0.f, 0.f, 0.f};
                sv[bj][n] = cscale ? *(const f32x4*)(cscale + col0 + bj * HALF + n * 16) : (f32x4){1.f, 1.f, 1.f, 1.f}; }
#pragma unroll
        for (int ai = 0; ai < 2; ++ai)
#pragma unroll
            for (int m = 0; m < 4; ++m) { float* rowp = C + (size_t)u.pk * kslab + (size_t)(row0 + ai * HALF + m * 16) * ldc + col0;
#pragma unroll
                for (int bj = 0; bj < 2; ++bj)
#pragma unroll
                    for (int n = 0; n < 2; ++n) *(f32x4*)(rowp + bj * HALF + n * 16) = (acc[ai][bj][m][n] + bv[bj][n]) * sv[bj][n]; }
    }
};
struct EpiQRope {
    static constexpr bool PERM = false, AFTER_DRAIN = false;
    bf16_t* O; const float* cosT; const float* sinT; bf16_t* QD;
    __device__ __forceinline__ void operator()(const f32x4 (&acc)[2][2][4][2], const Unit& u, int wr, int wc, int fr, int fq) const {
        const int row0 = u.pm * BM + wr * 64 + fr;
#pragma unroll
        for (int bj = 0; bj < 2; ++bj) {
            const int gb = u.pn * BM + bj * HALF + wc * 32; const bool rp = ((gb >> 5) % 3) == 2;
#pragma unroll
            for (int ai = 0; ai < 2; ++ai)
#pragma unroll
                for (int m = 0; m < 4; ++m) { const int row = row0 + ai * HALF + m * 16;
                    f32x4 v0 = acc[ai][bj][m][0], v1 = acc[ai][bj][m][1];
                    if (rp) { const int pos = row < 16384 ? (row & 8191) : 8192 + ((row - 16384) & 7);
                        const f32x4 c = *(const f32x4*)(cosT + pos * 16 + 4 * fq), s = *(const f32x4*)(sinT + pos * 16 + 4 * fq);
                        const f32x4 n0 = v0 * c - v1 * s, n1 = v1 * c + v0 * s; v0 = n0; v1 = n1; }
                    bf16_t* p = O + (size_t)row * 1536 + gb + 4 * fq;
                    typedef unsigned u32x2 __attribute__((ext_vector_type(2)));
                    u32x2 w0, w1; w0.x = cvt_pk_bf16(v0[0], v0[1]); w0.y = cvt_pk_bf16(v0[2], v0[3]); w1.x = cvt_pk_bf16(v1[0], v1[1]); w1.y = cvt_pk_bf16(v1[2], v1[3]);
                    *(u32x2*)p = w0; *(u32x2*)(p + 16) = w1;
                    if (rp && row >= 16384) { const int t = row - 16384, h = (gb >> 5) / 3; bf16_t* q = QD + ((size_t)(t >> 3) * 128 + (t & 7) * 16 + h) * 288 + 256 + 4 * fq; *(u32x2*)q = w0; *(u32x2*)(q + 16) = w1; } }
        }
    }
};


struct EpiQD {
    static constexpr bool PERM = true, AFTER_DRAIN = false;
    bf16_t* QD;
    __device__ __forceinline__ void operator()(const f32x4 (&acc)[2][2][4][2], const Unit& u, int wr, int wc, int fr, int fq) const {
        const int row0 = u.pm * BM + wr * 64 + fr, h = u.pn, col0 = wc * 32 + 8 * fq;
#pragma unroll
        for (int ai = 0; ai < 2; ++ai)
#pragma unroll
            for (int m = 0; m < 4; ++m) { const int t = row0 + ai * HALF + m * 16; bf16_t* base = QD + ((size_t)(t >> 3) * 128 + (t & 7) * 16 + h) * 288 + col0;
#pragma unroll
                for (int bj = 0; bj < 2; ++bj) { const f32x4 v0 = acc[ai][bj][m][0], v1 = acc[ai][bj][m][1];
                    u32x4 w; w.x = cvt_pk_bf16(v0[0], v0[1]); w.y = cvt_pk_bf16(v0[2], v0[3]); w.z = cvt_pk_bf16(v1[0], v1[1]); w.w = cvt_pk_bf16(v1[2], v1[3]);
                    *(u32x4*)(base + bj * HALF) = w; } }
    }
};
template <int S> struct SplitOrder {
    Unit u0; bool valid;
    __host__ __device__ void init(int N, int G_, int c_) { const int nN = N / BM; valid = c_ < 4 * nN * S; u0.pk = c_ % S; const int t = c_ / S; u0.pm = t & 3; u0.pn = t >> 2; u0.nt = 0; (void)G_; }
    __host__ __device__ bool next(int i, Unit& u) const { if (i > 0 || !valid) return false; u = u0; return true; }
    __device__ __forceinline__ void a_ready(const Unit&) const {}
    __device__ __forceinline__ void done(const Unit&) const {}
};


template <int S> struct HybridOrder {
    StaticOrder so; Unit us; bool has_s; int nt_full, nt_slice;
    __host__ __device__ void init(int Mp, int N, int Kfull, int G_, int c_) { so.init(Mp, N, G_, c_); nt_full = Kfull / BK; nt_slice = Kfull / S / BK;
        const int cs = G_ - 1 - c_, nN = N / BM; has_s = cs < 4 * nN * S; us.pk = cs % S; const int t = cs / S; us.pm = 64 + (t & 3); us.pn = t >> 2; us.nt = nt_slice; }
    __host__ __device__ bool next(int i, Unit& u) const { if (i == 0) { const bool ok = so.next(0, u); u.nt = nt_full; return ok; } if (i == 1 && has_s) { u = us; return true; } return false; }
    __device__ __forceinline__ void a_ready(const Unit&) const {}
    __device__ __forceinline__ void done(const Unit&) const {}
};
struct EpiHybrid {
    static constexpr bool PERM = true, AFTER_DRAIN = false;
    bf16_t* O; int ldc; float* slabs; size_t kslab;
    __device__ __forceinline__ void operator()(const f32x4 (&acc)[2][2][4][2], const Unit& u, int wr, int wc, int fr, int fq) const {
        const int col0 = u.pn * BM + wc * 32 + 8 * fq;
        if (u.pm < 64) { const int row0 = u.pm * BM + wr * 64 + fr;
#pragma unroll
            for (int ai = 0; ai < 2; ++ai)
#pragma unroll
                for (int m = 0; m < 4; ++m) { bf16_t* rowp = O + (size_t)(row0 + ai * HALF + m * 16) * ldc + col0;
#pragma unroll
                    for (int bj = 0; bj < 2; ++bj) { const f32x4 v0 = acc[ai][bj][m][0], v1 = acc[ai][bj][m][1];
                        u32x4 w; w.x = cvt_pk_bf16(v0[0], v0[1]); w.y = cvt_pk_bf16(v0[2], v0[3]); w.z = cvt_pk_bf16(v1[0], v1[1]); w.w = cvt_pk_bf16(v1[2], v1[3]);
                        *(u32x4*)(rowp + bj * HALF) = w; } }
        } else { const int row0 = (u.pm - 64) * BM + wr * 64 + fr; float* C = slabs + (size_t)u.pk * kslab;
#pragma unroll
            for (int ai = 0; ai < 2; ++ai)
#pragma unroll
                for (int m = 0; m < 4; ++m) { float* rowp = C + (size_t)(row0 + ai * HALF + m * 16) * 1024 + col0;
#pragma unroll
                    for (int bj = 0; bj < 2; ++bj) { *(f32x4*)(rowp + bj * HALF) = acc[ai][bj][m][0]; *(f32x4*)(rowp + bj * HALF + 4) = acc[ai][bj][m][1]; } }
        }
    }
};

template <class Epi, class Sched, bool ALIGN_EPI = false, bool SP2 = false>
__device__ __forceinline__ void gemm_phase(PG8_LAS unsigned char* lds, const Gemm g, const Sched& S, const Epi& E) {
    const int tid = opaque_tid(), wid = __builtin_amdgcn_readfirstlane(tid >> 6), lane = tid & 63, wr = wid >> 2, wc = wid & 3, fr = lane & 15, fq = lane >> 4;
    const int K = g.K; int nt = K / BK;
    unsigned voffA[2], voffB[2];
#pragma unroll
    for (int i = 0; i < 2; ++i) { int R, C; stage_rc(tid * 16 + i * 8192, R, C); const int Rb = Epi::PERM ? ((R & ~31) + perm32(R & 31)) : R;
        voffA[i] = (unsigned)(R * g.lda + C) * 2u; voffB[i] = (unsigned)(Rb * g.ldb + C) * 2u; }
    const size_t kstep = (size_t)(BK * 2);
    const size_t hstepA = (size_t)HALF * g.lda * 2, hstepB = (size_t)HALF * g.ldb * 2;
    const size_t tstepA = 2 * hstepA, tstepB = 2 * hstepB; const size_t gstepA = (size_t)g.agroup * 2, kstepS = (size_t)K * 2;
    const unsigned ldsw = (unsigned)wid * 1024u;
    const int aoff = lds_byte(wr * 64 + fr, fq * 8), boff = lds_byte(wc * 32 + fr, fq * 8);
#define PG8_SA(b, h) (((b) * 2 + (h)) * HTB)
#define PG8_SB(b, h) ((4 + (b) * 2 + (h)) * HTB)
#define PG8_STAGE(bufoff, gbase, voff) do { _Pragma("unroll") for (int _i = 0; _i < 2; ++_i) \
        __builtin_amdgcn_global_load_lds((const unsigned*)((const char*)(gbase) + (voff)[_i]), (PG8_LAS unsigned*)(lds + (bufoff) + ldsw + _i * 8192), 16, 0, 0); } while (0)
#define PG8_LDA(dst, b, h) do { _Pragma("unroll") for (int m = 0; m < 4; ++m) _Pragma("unroll") for (int k = 0; k < 2; ++k) dst[m][k] = *(const PG8_LAS bf16x8*)(lds + PG8_SA(b, h) + aoff + m * 2048 + k * 1024); } while (0)
#define PG8_LDB(dst, b, h) do { _Pragma("unroll") for (int n = 0; n < 2; ++n) _Pragma("unroll") for (int k = 0; k < 2; ++k) dst[n][k] = *(const PG8_LAS bf16x8*)(lds + PG8_SB(b, h) + boff + n * 2048 + k * 1024); } while (0)
#define PG8_MMA(ai, bj, At, Bt) do { __builtin_amdgcn_s_setprio(1); _Pragma("unroll") for (int m = 0; m < 4; ++m) _Pragma("unroll") for (int n = 0; n < 2; ++n) _Pragma("unroll") for (int k = 0; k < 2; ++k) \
        acc[ai][bj][m][n] = __builtin_amdgcn_mfma_f32_16x16x32_bf16(Bt[n][k], At[m][k], acc[ai][bj][m][n], 0, 0, 0); __builtin_amdgcn_s_setprio(0); } while (0)
#define PG8_WAIT_V(n) asm volatile("s_waitcnt vmcnt(" #n ")" ::: "memory")
#define PG8_WAIT_L(n) asm volatile("s_waitcnt lgkmcnt(" #n ")" ::: "memory")
#define PG8_BAR __builtin_amdgcn_s_barrier()
#define PG8_SCHED __builtin_amdgcn_sched_barrier(0)
    Unit cur, nxt; int ui = 0;
    if (!S.next(0, cur)) return;
    if (cur.nt > 0) nt = cur.nt;
    f32x4 acc[2][2][4][2];
#pragma unroll
    for (int a = 0; a < 2; ++a)
#pragma unroll
        for (int b = 0; b < 2; ++b)
#pragma unroll
            for (int m = 0; m < 4; ++m)
#pragma unroll
                for (int n = 0; n < 2; ++n) acc[a][b][m][n] = (f32x4){0.f, 0.f, 0.f, 0.f};
    bf16x8 At[4][2], B0[2][2], B1[2][2];
    const char* cA = (const char*)g.A + (size_t)cur.pm * tstepA + (size_t)cur.pn * gstepA + (size_t)cur.pk * kstepS; const char* cB = (const char*)g.Bt + (size_t)cur.pn * tstepB + (size_t)cur.pk * kstepS;
    S.a_ready(cur);
    if constexpr (SP2) {
        PG8_STAGE(PG8_SB(0, 0), cB, voffB); PG8_STAGE(PG8_SB(0, 1), cB + hstepB, voffB); PG8_STAGE(PG8_SA(0, 0), cA, voffA); PG8_STAGE(PG8_SA(0, 1), cA + hstepA, voffA);
        if (wr == 1) PG8_BAR;
        PG8_WAIT_V(2); PG8_BAR;
        PG8_STAGE(PG8_SB(1, 0), cB + kstep, voffB); PG8_STAGE(PG8_SA(1, 0), cA + kstep, voffA); PG8_STAGE(PG8_SB(1, 1), cB + hstepB + kstep, voffB);
        PG8_WAIT_V(6); PG8_BAR;
    } else {
        PG8_STAGE(PG8_SB(0, 0), cB, voffB); PG8_STAGE(PG8_SA(0, 0), cA, voffA); PG8_STAGE(PG8_SB(0, 1), cB + hstepB, voffB); PG8_STAGE(PG8_SA(0, 1), cA + hstepA, voffA);
        if (wr == 1) PG8_BAR;
        PG8_WAIT_V(4); PG8_BAR;
        PG8_STAGE(PG8_SB(1, 0), cB + kstep, voffB); PG8_STAGE(PG8_SA(1, 0), cA + kstep, voffA); PG8_STAGE(PG8_SB(1, 1), cB + hstepB + kstep, voffB);
        PG8_WAIT_V(6); PG8_BAR;
    }
    for (;;) {
        const bool has_next = S.next(ui + 1, nxt);
        const char* nA = has_next ? (const char*)g.A + (size_t)nxt.pm * tstepA + (size_t)nxt.pn * gstepA + (size_t)nxt.pk * kstepS : cA; const char* nB = has_next ? (const char*)g.Bt + (size_t)nxt.pn * tstepB + (size_t)nxt.pk * kstepS : cB;
        for (int t = 0; t < nt; t += 2) {
            const bool last = (t == nt - 2);
            const char* a1 = cA + (size_t)(t + 1) * kstep;
            const char* a2 = last ? nA : cA + (size_t)(t + 2) * kstep; const char* b2 = last ? nB : cB + (size_t)(t + 2) * kstep;
            const char* a3 = a2 + kstep; const char* b3 = b2 + kstep;
            if (last && has_next) S.a_ready(nxt);
            if constexpr (SP2) {
            PG8_LDB(B0, 0, 0); PG8_LDB(B1, 0, 1); PG8_SCHED; PG8_LDA(At, 0, 0); PG8_STAGE(PG8_SA(1, 1), a1 + hstepA, voffA);
            PG8_WAIT_V(8); PG8_WAIT_L(0); PG8_BAR; PG8_MMA(0, 0, At, B0); PG8_MMA(0, 1, At, B1); PG8_BAR; PG8_SCHED;
            PG8_LDA(At, 0, 1); PG8_STAGE(PG8_SB(0, 0), b2, voffB); PG8_STAGE(PG8_SB(0, 1), b2 + hstepB, voffB); PG8_STAGE(PG8_SA(0, 0), a2, voffA);
            PG8_WAIT_V(8); PG8_WAIT_L(0); PG8_BAR; PG8_MMA(1, 0, At, B0); PG8_MMA(1, 1, At, B1); PG8_BAR; PG8_SCHED;
            PG8_LDB(B0, 1, 0); PG8_LDB(B1, 1, 1); PG8_SCHED; PG8_LDA(At, 1, 0); PG8_STAGE(PG8_SA(0, 1), a2 + hstepA, voffA);
            PG8_WAIT_V(8); PG8_WAIT_L(0); PG8_BAR; PG8_MMA(0, 0, At, B0); PG8_MMA(0, 1, At, B1); PG8_BAR; PG8_SCHED;
            PG8_LDA(At, 1, 1); PG8_STAGE(PG8_SB(1, 0), b3, voffB); PG8_STAGE(PG8_SB(1, 1), b3 + hstepB, voffB); PG8_STAGE(PG8_SA(1, 0), a3, voffA);
            PG8_WAIT_V(8); PG8_WAIT_L(0); PG8_BAR; PG8_MMA(1, 0, At, B0); PG8_MMA(1, 1, At, B1); PG8_BAR; PG8_SCHED;
            } else {
            PG8_LDB(B0, 0, 0); PG8_SCHED; PG8_LDA(At, 0, 0); PG8_STAGE(PG8_SA(1, 1), a1 + hstepA, voffA);
            PG8_WAIT_L(8); PG8_BAR; PG8_WAIT_L(0); PG8_MMA(0, 0, At, B0); PG8_BAR; PG8_SCHED;
            PG8_LDB(B1, 0, 1); PG8_STAGE(PG8_SB(0, 0), b2, voffB);
            PG8_BAR; PG8_WAIT_L(0); PG8_MMA(0, 1, At, B1); PG8_BAR;
            PG8_LDA(At, 0, 1); PG8_STAGE(PG8_SA(0, 0), a2, voffA);
            PG8_BAR; PG8_WAIT_L(0); PG8_MMA(1, 0, At, B0); PG8_BAR; PG8_SCHED;
            PG8_STAGE(PG8_SB(0, 1), b2 + hstepB, voffB);
            PG8_WAIT_V(6); PG8_BAR; PG8_MMA(1, 1, At, B1); PG8_BAR;
            PG8_LDB(B0, 1, 0); PG8_SCHED; PG8_LDA(At, 1, 0); PG8_STAGE(PG8_SA(0, 1), a2 + hstepA, voffA);
            PG8_WAIT_L(8); PG8_BAR; PG8_WAIT_L(0); PG8_MMA(0, 0, At, B0); PG8_BAR; PG8_SCHED;
            PG8_LDB(B1, 1, 1); PG8_STAGE(PG8_SB(1, 0), b3, voffB);
            PG8_BAR; PG8_WAIT_L(0); PG8_MMA(0, 1, At, B1); PG8_BAR;
            PG8_LDA(At, 1, 1); PG8_STAGE(PG8_SA(1, 0), a3, voffA);
            PG8_BAR; PG8_WAIT_L(0); PG8_MMA(1, 0, At, B0); PG8_BAR; PG8_SCHED;
            PG8_STAGE(PG8_SB(1, 1), b3 + hstepB, voffB);
            PG8_WAIT_V(6); PG8_BAR; PG8_MMA(1, 1, At, B1); PG8_BAR;
            }
        }
        if constexpr (ALIGN_EPI) { if (wr == 0) PG8_BAR; }
        if constexpr (!Epi::AFTER_DRAIN) { E(acc, cur, wr, wc, fr, fq); S.done(cur); }
        if (!has_next) break;
#pragma unroll
        for (int a = 0; a < 2; ++a)
#pragma unroll
            for (int b = 0; b < 2; ++b)
#pragma unroll
                for (int m = 0; m < 4; ++m)
#pragma unroll
                    for (int n = 0; n < 2; ++n) acc[a][b][m][n] = (f32x4){0.f, 0.f, 0.f, 0.f};
        cur = nxt; cA = nA; cB = nB; ++ui; nt = (cur.nt > 0) ? cur.nt : K / BK;
        if constexpr (ALIGN_EPI) { if (wr == 1) PG8_BAR; }
    }
    PG8_WAIT_V(0);
    if constexpr (!ALIGN_EPI) { if (wr == 0) PG8_BAR; }
    PG8_BAR;
    if constexpr (Epi::AFTER_DRAIN) { E.fused(acc, cur, wr, wc, fr, fq, lds, wid, lane); S.done(cur); }
#undef PG8_SA
#undef PG8_SB
#undef PG8_STAGE
#undef PG8_LDA
#undef PG8_LDB
#undef PG8_MMA
#undef PG8_WAIT_V
#undef PG8_WAIT_L
#undef PG8_BAR
#undef PG8_SCHED
}
}

constexpr int NWAVES = 8;
constexpr int DM = 1024, TSEQ = 8192, NPR = 16384, NSR = 1024, NR = NPR + NSR;
constexpr int NDB = 128, NDS = 8, NH = 16, QL = 512, KVL = 256, RD = 32, FF = 2816, FF2 = 5632, NPAGE = 64;
constexpr float EPS = 1e-6f;
constexpr float SC2 = 0.10206207261596575f * 1.4426950408889634f;
constexpr size_t OUT_KVP = 17825792, OUT_KRP = 22020096, OUT_KVS = 22544384, OUT_KRS = 22806528, OUT_PSP = 22839296, OUT_PSS = 22870016, OUT_CSP = 24836096, OUT_CSS = 24881152, OUT_TOTAL = 27764736;
constexpr size_t MiB = 1u << 20;
constexpr size_t WS_CTL = 0, CTL_ZERO_BYTES = 1 * MiB;
constexpr size_t WS_COS = 1 * MiB, WS_SIN = 2 * MiB, WS_SILUC = 3 * MiB, WS_MOD = 4 * MiB, WS_ADAT = 16 * MiB, WS_WDQKV = 40 * MiB, WS_WUQ = 42 * MiB, WS_WKVUP = 44 * MiB, WS_WO = 45 * MiB,
                 WS_POOLT = 47 * MiB, WS_WUP = 48 * MiB, WS_WDOWN = 70 * MiB, WS_HN = 82 * MiB, WS_TMP = 116 * MiB, WS_CQ = 184 * MiB, WS_CKV = 201 * MiB, WS_KRB = 210 * MiB, WS_QP = 212 * MiB,
                 WS_KN = 264 * MiB, WS_VV = 296 * MiB, WS_O = 328 * MiB, WS_QD = 362 * MiB, WS_DPART = 372 * MiB, WS_DML = 404 * MiB, WS_U = 406 * MiB, WS_A2 = 594 * MiB, WS_H1 = 688 * MiB,
                 WS_POOLED = 756 * MiB, WS_XB = 722 * MiB, WS_WABS = 790 * MiB, WS_TMPS = 794 * MiB, WS_END = 840 * MiB;
constexpr int CW_BAR = 4096;
constexpr int RING_BYTES = 151552, LDSCTL_OFF = RING_BYTES, MISC_OFF = LDSCTL_OFF + 320, LDS_BYTES = 153600;

#define GAS __attribute__((address_space(1)))
#define LAS __attribute__((address_space(3)))
typedef unsigned short bf16;
typedef unsigned v4u __attribute__((ext_vector_type(4)));
typedef unsigned v2u __attribute__((ext_vector_type(2)));
typedef float f32x4 __attribute__((ext_vector_type(4)));
typedef float f32x2 __attribute__((ext_vector_type(2)));
typedef float f32x16 __attribute__((ext_vector_type(16)));
typedef short bf16x8 __attribute__((ext_vector_type(8)));
typedef short s16x4 __attribute__((ext_vector_type(4)));
typedef GAS unsigned gu32;
#define RLX_AGENT __ATOMIC_RELAXED, __HIP_MEMORY_SCOPE_AGENT
#define LDS_WAIT() asm volatile("s_waitcnt lgkmcnt(0)" ::: "memory")
#define VM_WAIT() asm volatile("s_waitcnt vmcnt(0)" ::: "memory")
__device__ __forceinline__ unsigned f2bf(float f) { unsigned u = __builtin_bit_cast(unsigned, f); return (u + 0x7fffu + ((u >> 16) & 1u)) >> 16; }

__device__ __forceinline__ float bf2f(unsigned h) { return __builtin_bit_cast(float, h << 16); }
__device__ __forceinline__ float bflo(unsigned w) { return __builtin_bit_cast(float, w << 16); }
__device__ __forceinline__ float bfhi(unsigned w) { return __builtin_bit_cast(float, w & 0xffff0000u); }
typedef __bf16 bf16x2_t __attribute__((ext_vector_type(2)));
__device__ __forceinline__ unsigned cvtpk(float lo, float hi) { const f32x2 v = {lo, hi}; const bf16x2_t b = __builtin_convertvector(v, bf16x2_t); return __builtin_bit_cast(unsigned, b); }
__device__ __forceinline__ unsigned pk2(float lo, float hi) { return cvtpk(lo, hi); }

#define XB_TMO      128
#define XB_XCNT(j)  (256  + 64 * (j))
#define XB_XSUB(j)  (1280 + 64 * (j))
#define XB_XGEN(j)  (2304 + 64 * (j))
#define XB_TOP      3328
#define XB_TOPGEN   3392
#define XCD_BAR_WORDS 3456
#define XB_SPIN_CAP (1u << 18)

__device__ __forceinline__ unsigned xb_ld(unsigned* p)              { return __hip_atomic_load(p, __ATOMIC_RELAXED, __HIP_MEMORY_SCOPE_AGENT); }
__device__ __forceinline__ unsigned xb_add(unsigned* p, unsigned v) { return __hip_atomic_fetch_add(p, v, __ATOMIC_RELAXED, __HIP_MEMORY_SCOPE_AGENT); }
__device__ __forceinline__ unsigned xb_xcc_id() { return (unsigned)__builtin_amdgcn_s_getreg((3 << 11) | 20) & 0xFu; }
#define XB_SPIN(cond, bar) do { unsigned _sp = 0; while (cond) { __builtin_amdgcn_s_sleep(1); \
    if ((++_sp & 255u) == 0u) { if (xb_ld(&(bar)[XB_TMO])) break; if (_sp > XB_SPIN_CAP) { atomicAdd(&(bar)[XB_TMO], 1u); break; } } } } while (0)

struct XcdBarrier {
    unsigned* bar; unsigned x;
    volatile LAS unsigned* st;
};

__device__ __forceinline__ XcdBarrier xcd_barrier_post(unsigned* bar, volatile LAS unsigned* st) {
    XcdBarrier b; b.bar = bar; b.x = xb_xcc_id(); b.st = st;
    if (threadIdx.x == 0) (void)xb_add(&bar[XB_XCNT(b.x)], 1u);
    return b;
}
__device__ __forceinline__ void xcd_barrier_complete(unsigned* bar, unsigned x, unsigned& nloc, unsigned& nx) {
    const unsigned G = gridDim.x * gridDim.y * gridDim.z;
    unsigned sum, cnt, mine, sp = 0u;
    for (;;) {
        sum = 0u; cnt = 0u; mine = 0u;
#pragma unroll
        for (unsigned j = 0; j < 16; ++j) { const unsigned c = xb_ld(&bar[XB_XCNT(j)]); sum += c; cnt += (c > 0u) ? 1u : 0u; mine = (j == x) ? c : mine; }
        if (sum == G) break;
        __builtin_amdgcn_s_sleep(1);
        if ((++sp & 255u) == 0u) { if (xb_ld(&bar[XB_TMO])) break; if (sp > XB_SPIN_CAP) { atomicAdd(&bar[XB_TMO], 1u); break; } }
    }
    nloc = mine > 0u ? mine : 1u; nx = cnt > 0u ? cnt : 1u;
}

__device__ __forceinline__ void xcd_barrier(const XcdBarrier& b) {
    asm volatile("s_waitcnt vmcnt(0)" ::: "memory");
    __syncthreads();
    if (threadIdx.x == 0) {
        unsigned* bar = b.bar;
        __builtin_amdgcn_s_waitcnt(0);
        unsigned nloc = b.st[0], nx = b.st[1];
        if (nloc == 0u) { xcd_barrier_complete(bar, b.x, nloc, nx); b.st[0] = nloc; b.st[1] = nx; }
        const unsigned old = xb_add(&bar[XB_XSUB(b.x)], 1u);
        const unsigned gen = old / nloc;
        if (old + 1u == (gen + 1u) * nloc) {
            __builtin_amdgcn_fence(__ATOMIC_RELEASE, "agent");
            asm volatile("s_waitcnt vmcnt(0)" ::: "memory");
            const unsigned og = xb_add(&bar[XB_TOP], 1u);
            const unsigned tg = og / nx;
            if (og + 1u == (tg + 1u) * nx) xb_add(&bar[XB_TOPGEN], 1u);
            else XB_SPIN(xb_ld(&bar[XB_TOPGEN]) == tg, bar);
            __builtin_amdgcn_fence(__ATOMIC_ACQUIRE, "agent");
            xb_add(&bar[XB_XGEN(b.x)], 1u);
            asm volatile("s_waitcnt vmcnt(0)" ::: "memory");
        } else {
            XB_SPIN(xb_ld(&bar[XB_XGEN(b.x)]) == gen, bar);
            __builtin_amdgcn_fence(__ATOMIC_ACQUIRE, "agent");
            asm volatile("s_waitcnt vmcnt(0)" ::: "memory");
        }
    }
    __syncthreads();
}

struct Args { const void* in[29]; float* out; unsigned char* ws; int ph_lo, ph_hi; };
struct Frame { LAS unsigned char* lds; volatile LAS unsigned* MISC; gu32* ctl; int tid, lane, wave, vcu, G; };

__device__ __forceinline__ float wave_sum(float v) {
#pragma unroll
    for (int o = 1; o < 64; o <<= 1) v += __shfl_xor(v, o);
    return v;
}
__device__ __forceinline__ float dot4(f32x4 a, f32x4 b) { return (a.x * b.x + a.y * b.y) + (a.z * b.z + a.w * b.w); }

__device__ __forceinline__ void p0_transpose_item(const float* W, int K, int N, bf16* WT, int row_off, LAS float* scr, int item, int lane) {
    const int nblk = N / 32, kb = item / nblk, nb = item % nblk, k0 = 64 * kb, n0 = 32 * nb;
#pragma unroll 8
    for (int i = 0; i < 32; ++i) { const int kk = 2 * i + (lane >> 5); scr[kk * 33 + (lane & 31)] = W[(size_t)(k0 + kk) * N + n0 + (lane & 31)]; }
    LDS_WAIT(); asm volatile("" ::: "memory");
    const int c = lane & 7;
#pragma unroll
    for (int j = 0; j < 4; ++j) { const int n = (lane >> 3) + 8 * j; const LAS float* s = scr + (8 * c) * 33 + n;
        v4u o; o.x = pk2(s[0 * 33], s[1 * 33]); o.y = pk2(s[2 * 33], s[3 * 33]); o.z = pk2(s[4 * 33], s[5 * 33]); o.w = pk2(s[6 * 33], s[7 * 33]);
        *(GAS v4u*)(WT + (size_t)(row_off + n0 + n) * K + k0 + 8 * c) = o; }
    LDS_WAIT(); asm volatile("" ::: "memory");
}

#ifndef DEFER_ALL
#define DEFER_ALL 0
#endif
template <int PART>
__device__ __forceinline__ void ph_prologue(const Frame& F, const Args& a, int wv, int nwv) {
    LAS float* scr = (LAS float*)(F.lds + F.wave * 16384);
    unsigned char* ws = a.ws;
    const int gw = wv, NGW = nwv;
    constexpr int I_ADA = 16 * 192, I_DQ = 16 * 16, I_DKV = 16 * 9, I_UQ = 8 * 48, I_UK = 4 * 32, I_WO = 16 * 32, I_POOL = 4 * 8, I_UP = 16 * 176, I_DOWN = 44 * 32;
    constexpr int NITEMS = 2 * I_ADA + I_DQ + I_DKV + I_UQ + 2 * I_UK + I_WO + 4 * I_POOL + 2 * I_UP + 2 * I_DOWN;
    constexpr int SPLIT = 2 * I_ADA + (DEFER_ALL ? 0 : 3584);
    for (int it = (PART == 0 ? gw : SPLIT + gw); it < (PART == 0 ? SPLIT : NITEMS); it += NGW) {
        int r = it;
        if (r < 2 * I_ADA) { const int l = r / I_ADA; p0_transpose_item((const float*)a.in[9] + (size_t)l * 1024 * 6144, 1024, 6144, (bf16*)(ws + WS_ADAT), l * 6144, scr, r % I_ADA, F.lane); continue; } r -= 2 * I_ADA;
        if (r < I_DQ) { p0_transpose_item((const float*)a.in[15], 1024, 512, (bf16*)(ws + WS_WDQKV), 0, scr, r, F.lane); continue; } r -= I_DQ;
        if (r < I_DKV) { p0_transpose_item((const float*)a.in[18], 1024, 288, (bf16*)(ws + WS_WDQKV), 512, scr, r, F.lane); continue; } r -= I_DKV;
        if (r < I_UQ) { p0_transpose_item((const float*)a.in[17], 512, 1536, (bf16*)(ws + WS_WUQ), 0, scr, r, F.lane); continue; } r -= I_UQ;
        if (r < I_UK) { p0_transpose_item((const float*)a.in[20], 256, 1024, (bf16*)(ws + WS_WKVUP), 0, scr, r, F.lane); continue; } r -= I_UK;
        if (r < I_UK) { p0_transpose_item((const float*)a.in[21], 256, 1024, (bf16*)(ws + WS_WKVUP), 1024, scr, r, F.lane); continue; } r -= I_UK;
        if (r < I_WO) { p0_transpose_item((const float*)a.in[22], 1024, 1024, (bf16*)(ws + WS_WO), 0, scr, r, F.lane); continue; } r -= I_WO;
        if (r < 4 * I_POOL) { const int g = r / I_POOL; p0_transpose_item((const float*)a.in[23] + (size_t)g * 65536, 256, 256, (bf16*)(ws + WS_POOLT), g * 256, scr, r % I_POOL, F.lane); continue; } r -= 4 * I_POOL;
        if (r < 2 * I_UP) { const int l = r / I_UP; p0_transpose_item((const float*)a.in[25] + (size_t)l * 1024 * FF2, 1024, FF2, (bf16*)(ws + WS_WUP) + (size_t)l * FF2 * 1024, 0, scr, r % I_UP, F.lane); continue; } r -= 2 * I_UP;
        { const int l = r / I_DOWN; p0_transpose_item((const float*)a.in[28] + (size_t)l * FF * 1024, FF, 1024, (bf16*)(ws + WS_WDOWN) + (size_t)l * 1024 * FF, 0, scr, r % I_DOWN, F.lane); }
    }
    if (PART == 1)
    for (int it = NGW - 1 - gw; it < 512; it += NGW) { const int h = it >> 5, kb = (it >> 3) & 3, cb = it & 7; const float* wuq = (const float*)a.in[17]; const float* wuk = (const float*)a.in[20];
#pragma unroll 8
        for (int i = 0; i < 64; ++i) scr[i * 64 + F.lane] = wuq[(size_t)(cb * 64 + i) * 1536 + h * 96 + F.lane];
        f32x4 wk[16];
#pragma unroll
        for (int n = 0; n < 16; ++n) wk[n] = *(const f32x4*)(wuk + (size_t)(kb * 64 + F.lane) * 1024 + h * 64 + 4 * n);
        LDS_WAIT(); asm volatile("" ::: "memory");
#pragma unroll 1
        for (int c2 = 0; c2 < 32; ++c2) { float s0 = 0.f, s1 = 0.f; const LAS float* q = scr + c2 * 128;
#pragma unroll
            for (int n = 0; n < 16; ++n) { s0 += dot4(wk[n], *(const LAS f32x4*)(q + 4 * n)); s1 += dot4(wk[n], *(const LAS f32x4*)(q + 64 + 4 * n)); }
            *(GAS unsigned*)((bf16*)(ws + WS_WABS) + (size_t)(h * 256 + kb * 64 + F.lane) * 512 + cb * 64 + c2 * 2) = pk2(s0, s1); }
        LDS_WAIT(); asm volatile("" ::: "memory");
    }
    const int gt = gw * 64 + F.lane, NGT = NGW * 64;
    if (PART == 1) for (int i = gt; i < 224 * 128; i += NGT) *(GAS v4u*)(ws + WS_WDQKV + (size_t)800 * 2048 + (size_t)i * 16) = (v4u){0u, 0u, 0u, 0u};
    if (PART == 1) return;
    for (int i = gt; i < 256 * 128; i += NGT) { const int r = i >> 7, d = (i & 127) * 8; v4u o = (v4u){0u, 0u, 0u, 0u};
        if (r < 130) { const float* c = r < 2 ? (const float*)a.in[7] + r * 1024 + d : (const float*)a.in[8] + (r - 2) * 1024 + d; float v[8];
#pragma unroll
            for (int e = 0; e < 8; ++e) { const float x = c[e]; v[e] = x / (1.f + __expf(-x)); }
            o.x = pk2(v[0], v[1]); o.y = pk2(v[2], v[3]); o.z = pk2(v[4], v[5]); o.w = pk2(v[6], v[7]); }
        *(GAS v4u*)(ws + WS_SILUC + (size_t)i * 16) = o; }
    for (int i = gt; i < 8200 * 16; i += NGT) { const int pos = i >> 4, k = i & 15;
        const double inv = exp2(-(double)k * (13.287712379549449 / 16.0)); const double ang = (double)pos * inv;
        const double kk = rint(ang * 0.15915494309189535); double r = fma(-kk, 6.283185307179586, ang); r = fma(-kk, 2.4492935982947064e-16, r);
        const double r2 = r * r; double s = 1.0, c = 1.0;
#pragma unroll
        for (int n = 13; n >= 1; --n) { s = 1.0 - s * r2 * (1.0 / ((2.0 * n) * (2.0 * n + 1.0))); c = 1.0 - c * r2 * (1.0 / ((2.0 * n - 1.0) * (2.0 * n))); }
        s *= r;
        ((float*)(ws + WS_COS))[i] = (float)c; ((float*)(ws + WS_SIN))[i] = (float)s; }
}

template <bool HAS_Y>
__device__ __forceinline__ void rowop_load(int row, int lane, const float* xa, const float* xb, const bf16* XB, const bf16* Yb, bool has_ys, const f32x4 (&ysc)[4], const float* YS, int nsplit, f32x4 (&x)[4], f32x4 (&y)[4]) {
    if (XB) {
#pragma unroll
        for (int j = 0; j < 4; ++j) { const v2u v = *(const v2u*)(XB + (size_t)row * DM + 4 * lane + 256 * j); x[j] = (f32x4){bflo(v.x), bfhi(v.x), bflo(v.y), bfhi(v.y)}; }
    } else { const float* xr = row < NPR ? xa + (size_t)row * DM : xb + (size_t)(row - NPR) * DM;
#pragma unroll
        for (int j = 0; j < 4; ++j) x[j] = *(const f32x4*)(xr + 4 * lane + 256 * j); }
    if (HAS_Y) {
#pragma unroll
        for (int j = 0; j < 4; ++j) {
            if (row < NPR || nsplit == 0) { const v2u v = *(const v2u*)(Yb + (size_t)row * DM + 4 * lane + 256 * j); y[j] = (f32x4){bflo(v.x), bfhi(v.x), bflo(v.y), bfhi(v.y)}; }
            else { y[j] = (f32x4){0.f, 0.f, 0.f, 0.f};
                for (int s = 0; s < nsplit; ++s) y[j] = y[j] + *(const f32x4*)(YS + ((size_t)s * NSR + (row - NPR)) * DM + 4 * lane + 256 * j); }
            if (has_ys) y[j] = y[j] * ysc[j]; }
    }
}
struct ModVec { f32x4 g[4], sc[4], sh[4]; int bi; };
template <bool HAS_Y, int OUTM>
__device__ __forceinline__ void modvec_load(ModVec& mv, int bi, int lane, const float* MOD, int og, int osh, int osc) {
    if (bi == mv.bi) return;
    const float* modr = MOD + (size_t)bi * 12288; mv.bi = bi;
#pragma unroll
    for (int j = 0; j < 4; ++j) { const int d = 4 * lane + 256 * j;
        if (HAS_Y) mv.g[j] = *(const f32x4*)(modr + og + d);
        if (OUTM != 0) { mv.sc[j] = *(const f32x4*)(modr + osc + d); mv.sh[j] = *(const f32x4*)(modr + osh + d); } }
}
template <bool HAS_Y, int OUTM>
__device__ __forceinline__ void rowop_finish(int row, int lane, f32x4 (&x)[4], const f32x4 (&y)[4], float* X, bf16* XBo, const ModVec& mv, const f32x4 (&wpo)[4], const f32x4 (&wpr)[4], bf16* HN, float* out) {
    if (HAS_Y) {
        float ss = 0.f;
#pragma unroll
        for (int j = 0; j < 4; ++j) ss += dot4(y[j], y[j]);
        const float r = 1.f / sqrtf(wave_sum(ss) * (1.f / DM) + EPS);
#pragma unroll
        for (int j = 0; j < 4; ++j) {
            x[j] = x[j] + mv.g[j] * (y[j] * r * wpo[j]);
            if (XBo) { v2u o; o.x = pk2(x[j].x, x[j].y); o.y = pk2(x[j].z, x[j].w); *(v2u*)(XBo + (size_t)row * DM + 4 * lane + 256 * j) = o; x[j] = (f32x4){bflo(o.x), bfhi(o.x), bflo(o.y), bfhi(o.y)}; }
            else *(f32x4*)(X + (size_t)row * DM + 4 * lane + 256 * j) = x[j]; }
    }
    if (OUTM != 0) {
        float ss = 0.f;
#pragma unroll
        for (int j = 0; j < 4; ++j) ss += dot4(x[j], x[j]);
        const float r = 1.f / sqrtf(wave_sum(ss) * (1.f / DM) + EPS);
        float* st = nullptr;
        if (OUTM == 2) { if (row >= NPR) st = out + OUT_PSS + ((size_t)((row - NPR) >> 3) * 15 + 7 + ((row - NPR) & 7)) * DM;
                         else if ((row & 8191) >= 8177) st = out + OUT_PSP + ((size_t)(row >> 13) * 15 + ((row & 8191) - 8177)) * DM; }
#pragma unroll
        for (int j = 0; j < 4; ++j) { const int d = 4 * lane + 256 * j;
            const f32x4 h = (x[j] * r * wpr[j]) * (mv.sc[j] + 1.f) + mv.sh[j];
            v2u o; o.x = pk2(h.x, h.y); o.y = pk2(h.z, h.w); *(v2u*)(HN + (size_t)row * DM + d) = o;
            if (OUTM == 2 && st) *(f32x4*)(st + d) = h; }
    }
}
template <bool HAS_Y, int OUTM>
__device__ __forceinline__ void ph_rowop(const Frame& F, const float* xa, const float* xb, float* X, const bf16* Yb, const float* MOD, const float* yscale, int og, const float* wpost,
                                         int osh, int osc, const float* wpre, bf16* HN, float* out, const float* YS = nullptr, int nsplit = 0, const bf16* XBi = nullptr, bf16* XBo = nullptr) {
    const int gw = F.vcu * NWAVES + F.wave, NGW = F.G * NWAVES, lane = F.lane;
    f32x4 wpo[4], wpr[4];
#pragma unroll
    for (int j = 0; j < 4; ++j) { wpo[j] = HAS_Y ? *(const f32x4*)(wpost + 4 * lane + 256 * j) : (f32x4){0.f, 0.f, 0.f, 0.f}; wpr[j] = OUTM != 0 ? *(const f32x4*)(wpre + 4 * lane + 256 * j) : (f32x4){0.f, 0.f, 0.f, 0.f}; }
    ModVec mv; mv.bi = -1;
    f32x4 ysc[4]; const bool has_ys = yscale != nullptr;
#pragma unroll
    for (int j = 0; j < 4; ++j) ysc[j] = has_ys ? *(const f32x4*)(yscale + 4 * lane + 256 * j) : (f32x4){1.f, 1.f, 1.f, 1.f};
    for (int row = gw; row < NR; row += 2 * NGW) {
        const int row2 = row + NGW; const bool two = row2 < NR;
        f32x4 x0[4], y0[4], x1[4], y1[4];
        rowop_load<HAS_Y>(row, lane, xa, xb, XBi, Yb, has_ys, ysc, YS, nsplit, x0, y0);
        if (two) rowop_load<HAS_Y>(row2, lane, xa, xb, XBi, Yb, has_ys, ysc, YS, nsplit, x1, y1);
        modvec_load<HAS_Y, OUTM>(mv, row < NPR ? (row >> 13) : 2 + ((row - NPR) >> 3), lane, MOD, og, osh, osc);
        rowop_finish<HAS_Y, OUTM>(row, lane, x0, y0, X, XBo, mv, wpo, wpr, HN, out);
        if (two) { modvec_load<HAS_Y, OUTM>(mv, row2 < NPR ? (row2 >> 13) : 2 + ((row2 - NPR) >> 3), lane, MOD, og, osh, osc);
                   rowop_finish<HAS_Y, OUTM>(row2, lane, x1, y1, X, XBo, mv, wpo, wpr, HN, out); }
    }
}

__device__ __forceinline__ void ph_qkvpost(const Frame& F, const Args& a) {
    unsigned char* ws = a.ws; const float* TMP = (const float*)(ws + WS_TMP); const float* qn = (const float*)a.in[16]; const float* kvn = (const float*)a.in[19];
    const float* cosT = (const float*)(ws + WS_COS); const float* sinT = (const float*)(ws + WS_SIN);
    bf16* CQ = (bf16*)(ws + WS_CQ); bf16* CKV = (bf16*)(ws + WS_CKV); bf16* KRB = (bf16*)(ws + WS_KRB); float* out = a.out;
    const int gw = F.vcu * NWAVES + F.wave, NGW = F.G * NWAVES, lane = F.lane;
    const f32x4 w0 = *(const f32x4*)(qn + 4 * lane), w1 = *(const f32x4*)(qn + 256 + 4 * lane), wk = *(const f32x4*)(kvn + 4 * lane);
    for (int row = gw; row < NR; row += NGW) {
        const float* t = (const float*)(ws + WS_TMPS) + (size_t)(row - NPR) * 1024;
        f32x4 a0, a1, kk; float x1 = 0.f, x2 = 0.f;
        if (row < NPR) { const bf16* tb = (const bf16*)TMP + (size_t)row * 1024; const v2u v0 = *(const v2u*)(tb + 4 * lane), v1 = *(const v2u*)(tb + 256 + 4 * lane), v2 = *(const v2u*)(tb + 512 + 4 * lane);
            a0 = (f32x4){bflo(v0.x), bfhi(v0.x), bflo(v0.y), bfhi(v0.y)}; a1 = (f32x4){bflo(v1.x), bfhi(v1.x), bflo(v1.y), bfhi(v1.y)}; kk = (f32x4){bflo(v2.x), bfhi(v2.x), bflo(v2.y), bfhi(v2.y)};
            if (lane < 16) { x1 = bf2f(tb[768 + lane]); x2 = bf2f(tb[784 + lane]); } }
        else { a0 = *(const f32x4*)(t + 4 * lane); a1 = *(const f32x4*)(t + 256 + 4 * lane); kk = *(const f32x4*)(t + 512 + 4 * lane); if (lane < 16) { x1 = t[768 + lane]; x2 = t[784 + lane]; } }
        if (row >= NPR) {
#pragma unroll
            for (int s = 1; s < 4; ++s) { const float* ts = t + (size_t)s * NSR * 1024; a0 = a0 + *(const f32x4*)(ts + 4 * lane); a1 = a1 + *(const f32x4*)(ts + 256 + 4 * lane); kk = kk + *(const f32x4*)(ts + 512 + 4 * lane);
                if (lane < 16) { x1 += ts[768 + lane]; x2 += ts[784 + lane]; } } }
        const float rq = 1.f / sqrtf(wave_sum(dot4(a0, a0) + dot4(a1, a1)) * (1.f / QL) + EPS);
        const float rk = 1.f / sqrtf(wave_sum(dot4(kk, kk)) * (1.f / KVL) + EPS);
        const f32x4 c0 = a0 * rq * w0, c1 = a1 * rq * w1, ck = kk * rk * wk;
        v2u o; o.x = pk2(c0.x, c0.y); o.y = pk2(c0.z, c0.w); *(v2u*)(CQ + (size_t)row * QL + 4 * lane) = o;
        o.x = pk2(c1.x, c1.y); o.y = pk2(c1.z, c1.w); *(v2u*)(CQ + (size_t)row * QL + 256 + 4 * lane) = o;
        float* okv = row < NPR ? out + OUT_KVP + (size_t)row * KVL : out + OUT_KVS + (size_t)(row - NPR) * KVL;
        *(f32x4*)(okv + 4 * lane) = ck;
        o.x = pk2(ck.x, ck.y); o.y = pk2(ck.z, ck.w); *(v2u*)(CKV + (size_t)row * KVL + 4 * lane) = o;
        if (lane < 16) { const int pos = row < NPR ? (row & 8191) : 8192 + ((row - NPR) & 7);
            const float c = cosT[pos * 16 + lane], s = sinT[pos * 16 + lane]; const float o1 = x1 * c - x2 * s, o2 = x2 * c + x1 * s;
            float* okr = row < NPR ? out + OUT_KRP + (size_t)row * RD : out + OUT_KRS + (size_t)(row - NPR) * RD;
            okr[lane] = o1; okr[16 + lane] = o2; KRB[(size_t)row * RD + lane] = (bf16)f2bf(o1); KRB[(size_t)row * RD + 16 + lane] = (bf16)f2bf(o2); }
    }
}

__device__ __forceinline__ s16x4 trrd(LAS unsigned char* p) { typedef short v4i16_t __attribute__((ext_vector_type(4))); return __builtin_bit_cast(s16x4, __builtin_amdgcn_ds_read_tr16_b64_v4i16((LAS v4i16_t*)p)); }
__device__ __forceinline__ bf16x8 cat8(s16x4 lo, s16x4 hi) { return (bf16x8){lo[0], lo[1], lo[2], lo[3], hi[0], hi[1], hi[2], hi[3]}; }
__device__ __forceinline__ bf16x8 pack8(float a0, float a1, float a2, float a3, float a4, float a5, float a6, float a7) {
    v4u w; w.x = cvtpk(a0, a1); w.y = cvtpk(a2, a3); w.z = cvtpk(a4, a5); w.w = cvtpk(a6, a7); return __builtin_bit_cast(bf16x8, w); }
#define EXP2(x) __builtin_amdgcn_exp2f(x)
#ifndef RESC_TAU
#define RESC_TAU 8.f
#endif

__device__ __forceinline__ float max3f(float a, float b, float c) { float r; asm volatile("v_max3_f32 %0, %1, %2, %3" : "=v"(r) : "v"(a), "v"(b), "v"(c)); return r; }
__device__ __forceinline__ float hmax32(float v) { auto rr = __builtin_amdgcn_permlane32_swap(__float_as_uint(v), __float_as_uint(v), false, false); return fmaxf(__uint_as_float(rr[0]), __uint_as_float(rr[1])); }
__device__ __forceinline__ void pattn_unit(LAS unsigned char* lds, const bf16* QP, const bf16* KN, const bf16* KRB, const bf16* VV, bf16* O, int b, int h, int qb) {
    const int tid = opaque_tid(), lane = tid & 63, wid = __builtin_amdgcn_readfirstlane(tid >> 6), r32 = lane & 31, hi = lane >> 5;
    constexpr int KP = 208, VP = 192, KBUF = 64 * KP, VBUF = 64 * VP, OFF_V = 2 * KBUF;
    const size_t rowb = (size_t)b * TSEQ; const int qw = qb * 256 + wid * 32;
    constexpr int OFF_Q = OFF_V + 2 * VBUF;
    LAS unsigned char* Qw = lds + OFF_Q + (wid * 32 + r32) * KP + hi * 16;
    { const bf16* qp = QP + (rowb + qw + r32) * 1536 + h * 96 + hi * 8;
#pragma unroll
      for (int d0 = 0; d0 < 6; ++d0) *(LAS bf16x8*)(Qw + d0 * 32) = *(const bf16x8*)(qp + d0 * 16); }
    const int lrow = tid >> 3, lch = tid & 7, rrow = (tid & 255) >> 2, rch = tid & 3; const bool hasr = tid < 256;
    const bf16* gkn = KN + (rowb + lrow) * 1024 + h * 64 + lch * 8;
    const bf16* gvv = VV + (rowb + lrow) * 1024 + h * 64 + lch * 8;
    const bf16* gkr = KRB + (rowb + rrow) * RD + rch * 8;
    const unsigned wK = lrow * KP + lch * 16, wV = OFF_V + lrow * VP + lch * 16, wR = rrow * KP + 128 + rch * 16;
    const int NT = 4 * qb + 4;
    const int q4 = (lane & 15) >> 2, p4 = lane & 3, blk = (lane >> 4) & 1;
    const unsigned vlane = (4 * hi + q4) * VP + (16 * blk + 4 * p4) * 2, klane = r32 * KP + hi * 16;
    const int qrel = wid * 32 + r32;
#define PA_QK(Kb, s0, s1) do { _Pragma("unroll") for (int r_ = 0; r_ < 16; ++r_) { s0[r_] = 0.f; s1[r_] = 0.f; } \
        _Pragma("unroll") for (int d0 = 0; d0 < 6; ++d0) { const bf16x8 q_ = *(const LAS bf16x8*)(Qw + d0 * 32), a0_ = *(const LAS bf16x8*)((Kb) + klane + d0 * 32), a1_ = *(const LAS bf16x8*)((Kb) + klane + 32 * KP + d0 * 32); \
            s0 = __builtin_amdgcn_mfma_f32_32x32x16_bf16(a0_, q_, s0, 0, 0, 0); s1 = __builtin_amdgcn_mfma_f32_32x32x16_bf16(a1_, q_, s1, 0, 0, 0); } } while (0)
#define PA_SOFTMAX(jt, s0, s1) do { \
        if ((jt) >= 4 * qb) { const int kb_ = 64 * ((jt) - 4 * qb) + 4 * hi; \
            _Pragma("unroll") for (int r_ = 0; r_ < 16; ++r_) { const int kv_ = kb_ + (r_ & 3) + 8 * (r_ >> 2); if (kv_ > qrel) s0[r_] = -INFINITY; if (kv_ + 32 > qrel) s1[r_] = -INFINITY; } } \
        float rm_ = fmaxf(s0[0], s1[0]); \
        _Pragma("unroll") for (int r_ = 1; r_ < 16; ++r_) rm_ = fmaxf(rm_, fmaxf(s0[r_], s1[r_])); \
        rm_ = hmax32(rm_) * SC2; \
        if (__any(rm_ > m)) { const float mn_ = fmaxf(m, rm_), al_ = EXP2(m - mn_); m = mn_; l *= al_; \
            _Pragma("unroll") for (int r_ = 0; r_ < 16; ++r_) { o0[r_] *= al_; o1[r_] *= al_; } } \
        float ps_ = 0.f; \
        _Pragma("unroll") for (int r_ = 0; r_ < 16; ++r_) { s0[r_] = EXP2(__builtin_fmaf(s0[r_], SC2, -m)); s1[r_] = EXP2(__builtin_fmaf(s1[r_], SC2, -m)); ps_ += s0[r_] + s1[r_]; } \
        l += ps_; \
        pf[0] = pack8(s0[0], s0[1], s0[2], s0[3], s0[4], s0[5], s0[6], s0[7]); pf[1] = pack8(s0[8], s0[9], s0[10], s0[11], s0[12], s0[13], s0[14], s0[15]); \
        pf[2] = pack8(s1[0], s1[1], s1[2], s1[3], s1[4], s1[5], s1[6], s1[7]); pf[3] = pack8(s1[8], s1[9], s1[10], s1[11], s1[12], s1[13], s1[14], s1[15]); } while (0)
#define PA_PV(Vb) do { _Pragma("unroll") for (int s_ = 0; s_ < 4; ++s_) { \
            { const bf16x8 vf_ = cat8(trrd((Vb) + vlane + (16 * s_) * VP), trrd((Vb) + vlane + (16 * s_ + 8) * VP)); o0 = __builtin_amdgcn_mfma_f32_32x32x16_bf16(vf_, pf[s_], o0, 0, 0, 0); } \
            { const bf16x8 vf_ = cat8(trrd((Vb) + vlane + (16 * s_) * VP + 64), trrd((Vb) + vlane + (16 * s_ + 8) * VP + 64)); o1 = __builtin_amdgcn_mfma_f32_32x32x16_bf16(vf_, pf[s_], o1, 0, 0, 0); } } } while (0)
#ifdef PROBE_PRO_QK2
#define PA_PROBE(Kb) do { f32x16 t0_, t1_; unsigned z_ = 0; asm volatile("" : "+v"(z_)); PA_QK((Kb) + z_, t0_, t1_); _Pragma("unroll") for (int r_ = 0; r_ < 16; ++r_) { sA0[r_] += (t0_[r_] - t0_[r_]); sA1[r_] += (t1_[r_] - t1_[r_]); } } while (0)
#elif defined(PROBE_PRO_SM2)
#define PA_PROBE(Kb) do { float x_ = 0.f; asm volatile("" : "+v"(x_)); _Pragma("unroll") for (int r_ = 0; r_ < 16; ++r_) { x_ += EXP2(__builtin_fmaf(sA0[r_], SC2, x_)) + EXP2(__builtin_fmaf(sA1[r_], SC2, -x_)); } l += (x_ - x_); } while (0)
#else
#define PA_PROBE(Kb) do {} while (0)
#endif
    float m = -INFINITY, l = 0.f; f32x16 o0, o1, sA0, sA1, sB0, sB1; bf16x8 pf[4], pfp[4];
#pragma unroll
    for (int r = 0; r < 16; ++r) { o0[r] = 0.f; o1[r] = 0.f; }
    v4u rkA, rvA, rrA;
#define PA_LOAD(rk_, rv_, rr_, kt, vt) do { if ((kt) < NT) { const size_t adv_ = (size_t)(kt) * 64; rk_ = *(const v4u*)(gkn + adv_ * 1024); if (hasr) rr_ = *(const v4u*)(gkr + adv_ * RD); } \
        if ((vt) < NT) { const size_t adv_ = (size_t)(vt) * 64; rv_ = *(const v4u*)(gvv + adv_ * 1024); } } while (0)
#define PA_STORE(rk_, rv_, rr_, kt, vt) do { if ((kt) < NT) { *(LAS v4u*)(lds + ((kt) & 1) * KBUF + wK) = rk_; if (hasr) *(LAS v4u*)(lds + ((kt) & 1) * KBUF + wR) = rr_; } \
        if ((vt) < NT) *(LAS v4u*)(lds + ((vt) & 1) * VBUF + wV) = rv_; } while (0)
#define PA_SM2(jt, MASKM, s0, s1, al_, resc_) do { \
        if ((MASKM) == 1 || ((MASKM) == 2 && (jt) >= 4 * qb)) { const int kb_ = 64 * ((jt) - 4 * qb) + 4 * hi; \
            _Pragma("unroll") for (int r_ = 0; r_ < 16; ++r_) { const int kv_ = kb_ + (r_ & 3) + 8 * (r_ >> 2); if (kv_ > qrel) s0[r_] = -INFINITY; if (kv_ + 32 > qrel) s1[r_] = -INFINITY; } } \
        float rm_ = max3f(s0[0], s1[0], s0[1]), rn_ = max3f(s1[1], s0[2], s1[2]); \
        _Pragma("unroll") for (int r_ = 3; r_ < 15; r_ += 2) { rm_ = max3f(rm_, s0[r_], s1[r_]); rn_ = max3f(rn_, s0[r_ + 1], s1[r_ + 1]); } \
        rm_ = max3f(rm_, rn_, s0[15]); rm_ = fmaxf(rm_, s1[15]); \
        rm_ = hmax32(rm_) * SC2; \
        resc_ = __any(rm_ > m + RESC_TAU); al_ = 1.f; \
        if (resc_) { const float mn_ = fmaxf(m, rm_); al_ = EXP2(m - mn_); m = mn_; l *= al_; } \
        float ps_ = 0.f; \
        _Pragma("unroll") for (int r_ = 0; r_ < 16; ++r_) { s0[r_] = EXP2(__builtin_fmaf(s0[r_], SC2, -m)); s1[r_] = EXP2(__builtin_fmaf(s1[r_], SC2, -m)); ps_ += s0[r_] + s1[r_]; } \
        l += ps_; \
        pf[0] = pack8(s0[0], s0[1], s0[2], s0[3], s0[4], s0[5], s0[6], s0[7]); pf[1] = pack8(s0[8], s0[9], s0[10], s0[11], s0[12], s0[13], s0[14], s0[15]); \
        pf[2] = pack8(s1[0], s1[1], s1[2], s1[3], s1[4], s1[5], s1[6], s1[7]); pf[3] = pack8(s1[8], s1[9], s1[10], s1[11], s1[12], s1[13], s1[14], s1[15]); } while (0)
#define PA_PV2(Vb) do { _Pragma("unroll") for (int s_ = 0; s_ < 4; ++s_) { \
            { const bf16x8 vf_ = cat8(trrd((Vb) + vlane + (16 * s_) * VP), trrd((Vb) + vlane + (16 * s_ + 8) * VP)); o0 = __builtin_amdgcn_mfma_f32_32x32x16_bf16(vf_, pfp[s_], o0, 0, 0, 0); } \
            { const bf16x8 vf_ = cat8(trrd((Vb) + vlane + (16 * s_) * VP + 64), trrd((Vb) + vlane + (16 * s_ + 8) * VP + 64)); o1 = __builtin_amdgcn_mfma_f32_32x32x16_bf16(vf_, pfp[s_], o1, 0, 0, 0); } } } while (0)
#define PA_IT(t_, DOQK, DOSM, DOPV, rkS, rvS, rrS, rkL, rvL, rrL) do { const int tt_ = (t_); float al_ = 1.f; bool resc_ = false; \
        PA_LOAD(rkS, rvS, rrS, tt_ + 2, tt_); \
        if (DOQK) { LAS unsigned char* Kn_ = lds + ((tt_ + 1) & 1) * KBUF; PA_QK(Kn_, sB0, sB1); } \
        if ((DOSM) != 0) PA_SM2(tt_, (DOSM) - 1, sA0, sA1, al_, resc_); \
        __builtin_amdgcn_sched_barrier(0); \
        if (DOPV) { LAS unsigned char* Vb_ = lds + OFF_V + ((tt_ - 1) & 1) * VBUF; PA_PV2(Vb_); } \
        if ((DOSM) != 0 && resc_) { _Pragma("unroll") for (int r_ = 0; r_ < 16; ++r_) { o0[r_] *= al_; o1[r_] *= al_; } } \
        if ((DOSM) != 0) { pfp[0] = pf[0]; pfp[1] = pf[1]; pfp[2] = pf[2]; pfp[3] = pf[3]; } \
        if (DOQK) { sA0 = sB0; sA1 = sB1; } \
        PA_STORE(rkS, rvS, rrS, tt_ + 2, tt_); \
        __syncthreads(); } while (0)
    { const v4u rk = *(const v4u*)gkn, rk1 = *(const v4u*)(gkn + (size_t)64 * 1024); v4u rr = (v4u){0u, 0u, 0u, 0u}, rr1 = rr; if (hasr) { rr = *(const v4u*)gkr; rr1 = *(const v4u*)(gkr + (size_t)64 * RD); }
      *(LAS v4u*)(lds + wK) = rk; if (hasr) *(LAS v4u*)(lds + wR) = rr;
      *(LAS v4u*)(lds + KBUF + wK) = rk1; if (hasr) *(LAS v4u*)(lds + KBUF + wR) = rr1; }
    __syncthreads();
    PA_QK(lds, sA0, sA1);
    __syncthreads();
    PA_IT(0, true, 3, false, rkA, rvA, rrA, rkA, rvA, rrA);
    if (qb > 0) {
#pragma unroll 1
        for (int t = 1; t < NT - 5; t += 2) {
            PA_IT(t, true, 1, true, rkA, rvA, rrA, rkA, rvA, rrA);
            PA_IT(t + 1, true, 1, true, rkA, rvA, rrA, rkA, rvA, rrA);
        }
        PA_IT(NT - 5, true, 1, true, rkA, rvA, rrA, rkA, rvA, rrA);
        PA_IT(NT - 4, true, 2, true, rkA, rvA, rrA, rkA, rvA, rrA);
    }
    PA_IT(NT - 3, true, 2, true, rkA, rvA, rrA, rkA, rvA, rrA);
    PA_IT(NT - 2, true, 2, true, rkA, rvA, rrA, rkA, rvA, rrA);
    PA_IT(NT - 1, false, 2, true, rkA, rvA, rrA, rkA, rvA, rrA);
    PA_IT(NT, false, 0, true, rkA, rvA, rrA, rkA, rvA, rrA);
#undef PA_LOAD
#undef PA_STORE
#undef PA_SM2
#undef PA_PV2
#undef PA_IT
#undef PA_QK
#undef PA_SOFTMAX
#undef PA_PV
    l += __shfl_xor(l, 32); const float inv = 1.f / l;
    bf16* op = O + (rowb + qw + r32) * 1024 + h * 64 + 4 * hi;
#pragma unroll
    for (int g4 = 0; g4 < 4; ++g4) { v2u w; w.x = cvtpk(o0[4 * g4] * inv, o0[4 * g4 + 1] * inv); w.y = cvtpk(o0[4 * g4 + 2] * inv, o0[4 * g4 + 3] * inv); *(v2u*)(op + 8 * g4) = w;
        w.x = cvtpk(o1[4 * g4] * inv, o1[4 * g4 + 1] * inv); w.y = cvtpk(o1[4 * g4 + 2] * inv, o1[4 * g4 + 3] * inv); *(v2u*)(op + 32 + 8 * g4) = w; }
}

template <bool NEWK>
__device__ __forceinline__ void dattn_step(LAS unsigned char* Kb, LAS unsigned char* Qw, f32x16 (&o)[8], float& m, float& l, unsigned klane, unsigned vlane, int hi, int stok) {
    constexpr int KP = 592;
    f32x16 p0, p1;
#pragma unroll
    for (int r = 0; r < 16; ++r) { p0[r] = 0.f; p1[r] = 0.f; }
    { bf16x8 fq[2][2], fa[2][2], fb[2][2];
#define DS_LD(set, g_) do { _Pragma("unroll") for (int e_ = 0; e_ < 2; ++e_) { const int ks_ = 2 * (g_) + e_; fq[set][e_] = *(const LAS bf16x8*)(Qw + klane + ks_ * 32); fa[set][e_] = *(const LAS bf16x8*)(Kb + klane + ks_ * 32); \
            if (!NEWK) fb[set][e_] = *(const LAS bf16x8*)(Kb + klane + 32 * KP + ks_ * 32); } } while (0)
#define DS_MM(set) do { _Pragma("unroll") for (int e_ = 0; e_ < 2; ++e_) { p0 = __builtin_amdgcn_mfma_f32_32x32x16_bf16(fa[set][e_], fq[set][e_], p0, 0, 0, 0); \
            if (!NEWK) p1 = __builtin_amdgcn_mfma_f32_32x32x16_bf16(fb[set][e_], fq[set][e_], p1, 0, 0, 0); } } while (0)
      DS_LD(0, 0);
#pragma unroll
      for (int g2 = 0; g2 < 9; g2 += 2) {
          if (g2 + 1 < 9) DS_LD(1, g2 + 1);
          __builtin_amdgcn_sched_barrier(0); DS_MM(0); __builtin_amdgcn_sched_barrier(0);
          if (g2 + 2 < 9) DS_LD(0, g2 + 2);
          __builtin_amdgcn_sched_barrier(0); if (g2 + 1 < 9) DS_MM(1); __builtin_amdgcn_sched_barrier(0);
      }
#undef DS_LD
#undef DS_MM
    }
    if (NEWK) {
#pragma unroll
        for (int r = 0; r < 16; ++r) { const int key = (r & 3) + 8 * (r >> 2) + 4 * hi; if (key > stok) p0[r] = -INFINITY; p1[r] = -INFINITY; } }
    float rm = fmaxf(p0[0], p1[0]);
#pragma unroll
    for (int r = 1; r < 16; ++r) rm = fmaxf(rm, fmaxf(p0[r], p1[r]));
    rm = hmax32(rm) * SC2;
    if (__any(rm > m + RESC_TAU)) { const float mn = fmaxf(m, rm), al = EXP2(m - mn); m = mn; l *= al;
#pragma unroll
        for (int c = 0; c < 8; ++c)
#pragma unroll
            for (int r = 0; r < 16; ++r) o[c][r] *= al; }
    float ps = 0.f;
#pragma unroll
    for (int r = 0; r < 16; ++r) { p0[r] = EXP2(__builtin_fmaf(p0[r], SC2, -m)); p1[r] = EXP2(__builtin_fmaf(p1[r], SC2, -m)); ps += p0[r] + p1[r]; }
    l += ps;
    bf16x8 pf[4];
    pf[0] = pack8(p0[0], p0[1], p0[2], p0[3], p0[4], p0[5], p0[6], p0[7]); pf[1] = pack8(p0[8], p0[9], p0[10], p0[11], p0[12], p0[13], p0[14], p0[15]);
    pf[2] = pack8(p1[0], p1[1], p1[2], p1[3], p1[4], p1[5], p1[6], p1[7]); pf[3] = pack8(p1[8], p1[9], p1[10], p1[11], p1[12], p1[13], p1[14], p1[15]);
    { constexpr int NG = NEWK ? 2 : 8; s16x4 vl[2][4], vh[2][4];
#define DV_LD(set, g_) do { const int s_ = (g_) >> 1, c0_ = 4 * ((g_) & 1); _Pragma("unroll") for (int e_ = 0; e_ < 4; ++e_) { \
            vl[set][e_] = trrd(Kb + vlane + (16 * s_) * KP + (c0_ + e_) * 64); vh[set][e_] = trrd(Kb + vlane + (16 * s_ + 8) * KP + (c0_ + e_) * 64); } } while (0)
#define DV_MM(set, g_) do { const int s_ = (g_) >> 1, c0_ = 4 * ((g_) & 1); _Pragma("unroll") for (int e_ = 0; e_ < 4; ++e_) \
            o[c0_ + e_] = __builtin_amdgcn_mfma_f32_32x32x16_bf16(cat8(vl[set][e_], vh[set][e_]), pf[s_], o[c0_ + e_], 0, 0, 0); } while (0)
      DV_LD(0, 0);
#pragma unroll
      for (int g2 = 0; g2 < NG; g2 += 2) {
          DV_LD(1, g2 + 1);
          __builtin_amdgcn_sched_barrier(0); DV_MM(0, g2); __builtin_amdgcn_sched_barrier(0);
          if (g2 + 2 < NG) DV_LD(0, g2 + 2);
          __builtin_amdgcn_sched_barrier(0); DV_MM(1, g2 + 1); __builtin_amdgcn_sched_barrier(0);
      }
#undef DV_LD
#undef DV_MM
    }
}
__device__ __forceinline__ void dattn_unit(LAS unsigned char* lds, const bf16* QD, const float* ckvc, const float* krc, const int* ptab, const bf16* CKV, const bf16* KRB, float* DPART, float* DML, int unit) {
    const int bd = unit >> 1, half = unit & 1;
    const int tid = opaque_tid(), lane = tid & 63, wid = __builtin_amdgcn_readfirstlane(tid >> 6), r32 = lane & 31, hi = lane >> 5;
    constexpr int KP = 592, KBUF = 64 * KP;
    const bool comp = wid < 4;
    for (int i = tid; i < 128 * 36; i += NWAVES * 64) { const int row = i / 36, ch = i % 36; *(LAS v4u*)(lds + 2 * KBUF + row * KP + ch * 16) = *(const v4u*)(QD + ((size_t)bd * 128 + row) * 288 + ch * 8); }
    const int* pt = ptab + bd * NPAGE;
    const int lt = tid & 255;
    f32x4 preA[18], preB[18], preC[18];
#define DLOAD(pre, T) do { const int T_ = (T); const size_t rb_ = (size_t)pt[T_ >> 1] * 128 + (size_t)(T_ & 1) * 64; const float* lp_ = ckvc + rb_ * 256; const float* rp_ = krc + rb_ * 32; \
        _Pragma("unroll") for (int i_ = 0; i_ < 16; ++i_) pre[i_] = __builtin_nontemporal_load((const f32x4*)(lp_ + (size_t)(lt + 256 * i_) * 4)); \
        _Pragma("unroll") for (int i_ = 0; i_ < 2; ++i_) pre[16 + i_] = __builtin_nontemporal_load((const f32x4*)(rp_ + (size_t)(lt + 256 * i_) * 4)); } while (0)
#define DSTORE(pre, buf) do { LAS unsigned char* b_ = lds + (buf) * KBUF; \
        _Pragma("unroll") for (int i_ = 0; i_ < 16; ++i_) { const int id_ = lt + 256 * i_; v2u w_; w_.x = cvtpk(pre[i_].x, pre[i_].y); w_.y = cvtpk(pre[i_].z, pre[i_].w); *(LAS v2u*)(b_ + (id_ >> 6) * KP + (id_ & 63) * 8) = w_; } \
        _Pragma("unroll") for (int i_ = 0; i_ < 2; ++i_) { const int id_ = lt + 256 * i_; v2u w_; w_.x = cvtpk(pre[16 + i_].x, pre[16 + i_].y); w_.y = cvtpk(pre[16 + i_].z, pre[16 + i_].w); *(LAS v2u*)(b_ + (id_ >> 3) * KP + 512 + (id_ & 7) * 8) = w_; } } while (0)
    const int T0 = half * 64;
    float m = -INFINITY, l = 0.f; f32x16 o[8];
    const int q4 = (lane & 15) >> 2, p4 = lane & 3, blk = (lane >> 4) & 1;
    const unsigned klane = r32 * KP + hi * 16, vlane = (4 * hi + q4) * KP + (16 * blk + 4 * p4) * 2;
    LAS unsigned char* Qw = lds + 2 * KBUF + (wid & 3) * 32 * KP;
    const int stok = 2 * (wid & 3) + (r32 >> 4);
    if (comp) {
#pragma unroll
        for (int c = 0; c < 8; ++c)
#pragma unroll
            for (int r = 0; r < 16; ++r) o[c][r] = 0.f;
        __syncthreads();
#pragma unroll 1
        for (int j = 0; j < 64; j += 2) {
            dattn_step<false>(lds, Qw, o, m, l, klane, vlane, hi, stok);
            __syncthreads();
            dattn_step<false>(lds + KBUF, Qw, o, m, l, klane, vlane, hi, stok);
            __syncthreads();
        }
    } else {
#define DTILE(pre, j_) do { DSTORE(pre, ((j_) + 1) & 1); DLOAD(pre, T0 + ((j_) + 4 < 64 ? (j_) + 4 : 63)); __syncthreads(); } while (0)
        DLOAD(preA, T0); DLOAD(preB, T0 + 1); DLOAD(preC, T0 + 2); DSTORE(preA, 0); DLOAD(preA, T0 + 3);
        __syncthreads();
#pragma unroll 1
        for (int j = 0; j < 60; j += 6) {
            DTILE(preB, j); DTILE(preC, j + 1); DTILE(preA, j + 2); DTILE(preB, j + 3); DTILE(preC, j + 4); DTILE(preA, j + 5);
        }
        DTILE(preB, 60); DTILE(preC, 61); DTILE(preA, 62); DTILE(preB, 63);
#undef DTILE
    }
#undef DLOAD
#undef DSTORE
    if (half == 1) {
        for (int i = tid; i < 32 * 36; i += NWAVES * 64) { const int row = i / 36, ch = i % 36; v4u v = (v4u){0u, 0u, 0u, 0u};
            if (row < 8) v = ch < 32 ? *(const v4u*)(CKV + (size_t)(NPR + bd * 8 + row) * KVL + ch * 8) : *(const v4u*)(KRB + (size_t)(NPR + bd * 8 + row) * RD + (ch - 32) * 8);
            *(LAS v4u*)(lds + row * KP + ch * 16) = v; }
        __syncthreads();
        if (comp) dattn_step<true>(lds, Qw, o, m, l, klane, vlane, hi, stok);
        __syncthreads();
    }
    if (comp) {
        l += __shfl_xor(l, 32);
        const int row = (wid & 3) * 32 + r32;
        float* dp = DPART + ((size_t)unit * 128 + row) * 256 + 4 * hi;
#pragma unroll
        for (int c = 0; c < 8; ++c)
#pragma unroll
            for (int g4 = 0; g4 < 4; ++g4) *(f32x4*)(dp + 32 * c + 8 * g4) = (f32x4){o[c][4 * g4], o[c][4 * g4 + 1], o[c][4 * g4 + 2], o[c][4 * g4 + 3]};
        if (hi == 0) { DML[((size_t)unit * 128 + row) * 2] = m; DML[((size_t)unit * 128 + row) * 2 + 1] = l; }
    }
}

__device__ __forceinline__ void ph_attention(const Frame& F, const Args& a) {
    unsigned char* ws = a.ws;
    const bf16* QP = (const bf16*)(ws + WS_QP); const bf16* KN = (const bf16*)(ws + WS_KN); const bf16* KRB = (const bf16*)(ws + WS_KRB); const bf16* VV = (const bf16*)(ws + WS_VV); bf16* O = (bf16*)(ws + WS_O);
#ifndef PROBE_DEC_REP
#define PROBE_DEC_REP 1
#endif
#ifndef PROBE_PRO_REP
#define PROBE_PRO_REP 1
#endif
#ifndef ATT_ORDER
#define ATT_ORDER 2
#endif
#define DEC_UNITS() do { _Pragma("unroll 1") for (int rep_ = 0; rep_ < PROBE_DEC_REP; ++rep_) _Pragma("unroll 1") for (int u = F.vcu; u < 2 * NDB; u += F.G) \
        dattn_unit(F.lds, (const bf16*)(ws + WS_QD), (const float*)a.in[2], (const float*)a.in[3], (const int*)a.in[6], (const bf16*)(ws + WS_CKV), KRB, (float*)(ws + WS_DPART), (float*)(ws + WS_DML), u); } while (0)
#define PRO_UNITS(i0_, i1_) do { _Pragma("unroll 1") for (int rep_ = 0; rep_ < PROBE_PRO_REP; ++rep_) { \
        if (F.G == 256) { const int xq = F.vcu >> 5, jq = F.vcu & 31; \
            _Pragma("unroll 1") for (int i = (i0_); i < (i1_); ++i) { const int bh = 4 * xq + i, qb = (i & 1) ? 31 - jq : jq; pattn_unit(F.lds, QP, KN, KRB, VV, O, bh >> 4, bh & 15, qb); } \
        } else if ((i0_) == 0) { _Pragma("unroll 1") for (int u = F.vcu; u < 1024; u += F.G) pattn_unit(F.lds, QP, KN, KRB, VV, O, u >> 9, (u >> 5) & 15, 31 - (u & 31)); } } } while (0)
#if ATT_ORDER == 2
    const int dpos = F.vcu % 3;
    if (dpos == 0) DEC_UNITS();
    if (F.G == 256) { const int xq = F.vcu >> 5, jq = F.vcu & 31;
#pragma unroll 1
        for (int i = 0; i < 4; ++i) { if (i == 2 && dpos == 1) DEC_UNITS();
            const int bh = 4 * xq + i, qb = (i & 1) ? 31 - jq : jq; pattn_unit(F.lds, QP, KN, KRB, VV, O, bh >> 4, bh & 15, qb); }
    } else { if (dpos == 1) DEC_UNITS(); PRO_UNITS(0, 4); }
    if (dpos == 2) DEC_UNITS();
#else
    const bool dec_first = ATT_ORDER ? (F.vcu & 1) : true;
    if (dec_first) DEC_UNITS();
    PRO_UNITS(0, 4);
    if (!dec_first) DEC_UNITS();
#endif
#undef DEC_UNITS
#undef PRO_UNITS
}

__device__ __forceinline__ void ph_dcombine(const Frame& F, const Args& a) {
    unsigned char* ws = a.ws;
    const float* DPART = (const float*)(ws + WS_DPART); const float* DML = (const float*)(ws + WS_DML); const float* wuv = (const float*)a.in[21]; bf16* O = (bf16*)(ws + WS_O);
    LAS float* olat = (LAS float*)F.lds;
    const int lane = F.lane, w = F.wave;
    for (int un = F.vcu; un < 2 * NDB; un += F.G) { const int bd = un >> 1, hh = un & 1;
#pragma unroll 4
        for (int h8 = 0; h8 < 8; ++h8) { const int r = w * 16 + 8 * hh + h8;
            const size_t u0 = (size_t)(bd * 2) * 128 + r, u1 = (size_t)(bd * 2 + 1) * 128 + r;
            const f32x2 ml0 = *(const f32x2*)(DML + u0 * 2), ml1 = *(const f32x2*)(DML + u1 * 2);
            const float M = fmaxf(ml0.x, ml1.x), w0 = EXP2(ml0.x - M), w1 = EXP2(ml1.x - M), L = ml0.y * w0 + ml1.y * w1;
            const f32x4 acc = *(const f32x4*)(DPART + u0 * 256 + 4 * lane) * w0 + *(const f32x4*)(DPART + u1 * 256 + 4 * lane) * w1;
            *(LAS f32x4*)(olat + (h8 * 8 + w) * 256 + ((4 * lane) ^ (4 * (h8 & 3)))) = acc * (1.f / L);
        }
        __syncthreads();
        { const int qd = w & 1, kq = w >> 1, hl = lane >> 4, h8 = 4 * qd + hl, h = 8 * hh + h8, v0 = 4 * (lane & 15), sw = 4 * hl;
          f32x4 acc[8];
#pragma unroll
          for (int s = 0; s < 8; ++s) acc[s] = (f32x4){0.f, 0.f, 0.f, 0.f};
          const float* wp = wuv + (size_t)(64 * kq) * 1024 + 256 * (2 * hh + qd) + 4 * lane; const LAS float* ob = olat + (h8 * 8) * 256;
#pragma unroll 4
          for (int kk = 0; kk < 16; ++kk) { const int k = 64 * kq + 4 * kk;
              const f32x4 w0 = *(const f32x4*)(wp + (size_t)(4 * kk) * 1024), w1 = *(const f32x4*)(wp + (size_t)(4 * kk + 1) * 1024), w2 = *(const f32x4*)(wp + (size_t)(4 * kk + 2) * 1024), w3 = *(const f32x4*)(wp + (size_t)(4 * kk + 3) * 1024);
#pragma unroll
              for (int s = 0; s < 8; ++s) { const f32x4 o = *(const LAS f32x4*)(ob + s * 256 + (k ^ sw)); acc[s] = acc[s] + w0 * o.x + w1 * o.y + w2 * o.z + w3 * o.w; } }
          __syncthreads();
          if (kq > 0) { LAS f32x4* xs = (LAS f32x4*)F.lds + (((kq - 1) * 2 + qd) * 64 + lane) * 8;
#pragma unroll
              for (int s = 0; s < 8; ++s) xs[s] = acc[s]; }
          __syncthreads();
          if (kq == 0) {
#pragma unroll
              for (int s = 0; s < 8; ++s) { f32x4 t = acc[s];
#pragma unroll
                  for (int q = 0; q < 3; ++q) t = t + ((const LAS f32x4*)F.lds)[((q * 2 + qd) * 64 + lane) * 8 + s];
                  v2u o; o.x = pk2(t.x, t.y); o.y = pk2(t.z, t.w); *(v2u*)(O + (size_t)(NPR + bd * 8 + s) * 1024 + h * 64 + v0) = o; } }
          __syncthreads();
        }
    }
}

__device__ __forceinline__ void ph_conv(const Frame& F, const Args& a, int L) {
    unsigned char* ws = a.ws; const bf16* U = (const bf16*)(ws + WS_U); bf16* A2 = (bf16*)(ws + WS_A2);
    const float* cw = (const float*)a.in[26] + (size_t)L * 3 * FF2; const float* cb = (const float*)a.in[27] + (size_t)L * FF2; const float* stc = (const float*)a.in[5] + (size_t)L * NDB * 2 * FF2;
    const int tid = F.tid;
    if (tid >= 352) return;
    const int c = 8 * tid, NI = NR / 8;
    f32x4 wgt[2][4][2];
#pragma unroll
    for (int p = 0; p < 2; ++p)
#pragma unroll
        for (int k = 0; k < 4; ++k) { const float* src = (k < 3 ? cw + (size_t)k * FF2 : cb) + p * FF + c; wgt[p][k][0] = *(const f32x4*)src; wgt[p][k][1] = *(const f32x4*)(src + 4); }
    const int ilast = F.vcu + ((NI - 1 - F.vcu) / F.G) * F.G;
#define CV_ROWPTR(item_, p_, i_) (U + (size_t)(((item_) < ilast ? (item_) : ilast) * 8 + (((i_) < 2 && ((((item_) < ilast ? (item_) : ilast) * 8 >= NPR) || (((((item_) < ilast ? (item_) : ilast) * 8) & 8191) == 0))) ? 0 : (i_) - 2)) * FF2 + (p_) * FF + c)
#define CV_UNPACK(dst, v) do { dst[0] = bflo((v).x); dst[1] = bfhi((v).x); dst[2] = bflo((v).y); dst[3] = bfhi((v).y); dst[4] = bflo((v).z); dst[5] = bfhi((v).z); dst[6] = bflo((v).w); dst[7] = bfhi((v).w); } while (0)
    v4u raw[2][10];
#pragma unroll
    for (int i = 0; i < 2; ++i)
#pragma unroll
        for (int p = 0; p < 2; ++p) raw[p][i] = *(const v4u*)CV_ROWPTR(F.vcu, p, i);
#pragma unroll
    for (int i = 2; i < 10; ++i)
#pragma unroll
        for (int p = 0; p < 2; ++p) raw[p][i] = *(const v4u*)CV_ROWPTR(F.vcu, p, i);
#pragma unroll 1
    for (int item = F.vcu; item < NI; item += F.G) {
        const int nxt = item + F.G;
        const int row0 = item * 8; const bool smp = row0 >= NPR; const int bd = (row0 - NPR) >> 3, t0 = row0 & 8191;
        float um2[2][8], um1[2][8];
#pragma unroll
        for (int i = 0; i < 2; ++i)
#pragma unroll
            for (int p = 0; p < 2; ++p) { if (i == 0) CV_UNPACK(um2[p], raw[p][0]); else CV_UNPACK(um1[p], raw[p][1]); raw[p][i] = *(const v4u*)CV_ROWPTR(nxt, p, i); }
#pragma unroll
        for (int p = 0; p < 2; ++p) {
            if (smp) { const float* s0 = stc + ((size_t)bd * 2) * FF2 + p * FF + c;
#pragma unroll
                for (int e = 0; e < 8; ++e) { um2[p][e] = s0[e]; um1[p][e] = s0[FF2 + e]; } }
            else if (t0 == 0) {
#pragma unroll
                for (int e = 0; e < 8; ++e) { um2[p][e] = 0.f; um1[p][e] = 0.f; } } }
#pragma unroll
        for (int t = 0; t < 8; ++t) { float cv[2][8];
#pragma unroll
            for (int p = 0; p < 2; ++p) { float u0[8]; CV_UNPACK(u0, raw[p][t + 2]); raw[p][t + 2] = *(const v4u*)CV_ROWPTR(nxt, p, t + 2);
#pragma unroll
                for (int h4 = 0; h4 < 2; ++h4) { const f32x4 k0 = wgt[p][0][h4], k1 = wgt[p][1][h4], k2 = wgt[p][2][h4], kb = wgt[p][3][h4];
#pragma unroll
                    for (int e4 = 0; e4 < 4; ++e4) { const int e = 4 * h4 + e4; cv[p][e] = kb[e4] + um2[p][e] * k0[e4] + um1[p][e] * k1[e4] + u0[e] * k2[e4]; um2[p][e] = um1[p][e]; um1[p][e] = u0[e]; } } }
            float g[8];
#pragma unroll
            for (int e = 0; e < 8; ++e) { const float x = cv[0][e]; g[e] = x * __builtin_amdgcn_rcpf(1.f + __builtin_amdgcn_exp2f(x * -1.4426950408889634f)) * cv[1][e]; }
            v4u o; o.x = cvtpk(g[0], g[1]); o.y = cvtpk(g[2], g[3]); o.z = cvtpk(g[4], g[5]); o.w = cvtpk(g[6], g[7]);
            *(v4u*)(A2 + (size_t)(row0 + t) * FF + c) = o; }
        if (smp || t0 == 8184) { float* so = smp ? a.out + OUT_CSS + ((size_t)(L * NDB + bd) * 2) * FF2 : a.out + OUT_CSP + ((size_t)(L * 2 + (row0 >> 13)) * 2) * FF2;
#pragma unroll
            for (int p = 0; p < 2; ++p)
#pragma unroll
                for (int e = 0; e < 8; ++e) { so[p * FF + c + e] = um2[p][e]; so[FF2 + p * FF + c + e] = um1[p][e]; } }
    }
#undef CV_ROWPTR
#undef CV_UNPACK
}

__device__ __forceinline__ void ph_pool(const Frame& F, const Args& a) {
    unsigned char* ws = a.ws; const bf16* H1 = (const bf16*)(ws + WS_H1); bf16* PO = (bf16*)(ws + WS_POOLED); const float* stp = (const float*)a.in[4];
    const int tid = F.tid, sub = tid >> 7, cg = tid & 127, d = 8 * cg, wdw = 2 << (cg >> 5);
#pragma unroll 1
    for (int item = 4 * F.vcu + sub; item < NR / 8; item += 4 * F.G) {
        const int row0 = item * 8; const bool smp = row0 >= NPR; const int bd = (row0 - NPR) >> 3, t0 = row0 & 8191;
        v4u r[23];
#pragma unroll
        for (int i = 0; i < 23; ++i) { const int tt = i - 15; r[i] = (v4u){0u, 0u, 0u, 0u};
            if (tt > -wdw) { if (smp && tt < 0) { const float* sp = stp + ((size_t)bd * 15 + 15 + tt) * DM + d; const f32x4 s0 = *(const f32x4*)sp, s1 = *(const f32x4*)(sp + 4);
                                 r[i].x = pk2(s0.x, s0.y); r[i].y = pk2(s0.z, s0.w); r[i].z = pk2(s1.x, s1.y); r[i].w = pk2(s1.z, s1.w); }
                             else if (smp || t0 + tt >= 0) r[i] = *(const v4u*)(H1 + (size_t)(row0 + tt) * DM + d); } }
        float sum[8];
#pragma unroll
        for (int e = 0; e < 8; ++e) sum[e] = 0.f;
#define PL_ACC(v, sgn) do { sum[0] += (sgn) * bflo((v).x); sum[1] += (sgn) * bfhi((v).x); sum[2] += (sgn) * bflo((v).y); sum[3] += (sgn) * bfhi((v).y); \
        sum[4] += (sgn) * bflo((v).z); sum[5] += (sgn) * bfhi((v).z); sum[6] += (sgn) * bflo((v).w); sum[7] += (sgn) * bfhi((v).w); } while (0)
#pragma unroll
        for (int i = 0; i < 15; ++i) if (i - 15 > -wdw) PL_ACC(r[i], 1.f);
#pragma unroll
        for (int t = 0; t < 8; ++t) { const v4u cur = r[15 + t]; PL_ACC(cur, 1.f);
            const int pc = t0 + t + 1; const float ic = 1.f / (smp ? (float)wdw : (float)(pc < wdw ? pc : wdw));
            v4u o; o.x = pk2(sum[0] * ic - bflo(cur.x), sum[1] * ic - bfhi(cur.x)); o.y = pk2(sum[2] * ic - bflo(cur.y), sum[3] * ic - bfhi(cur.y));
            o.z = pk2(sum[4] * ic - bflo(cur.z), sum[5] * ic - bfhi(cur.z)); o.w = pk2(sum[6] * ic - bflo(cur.w), sum[7] * ic - bfhi(cur.w));
            *(v4u*)(PO + (size_t)(row0 + t) * DM + d) = o;
            const v4u old = wdw == 2 ? r[14 + t] : wdw == 4 ? r[12 + t] : wdw == 8 ? r[8 + t] : r[t];
            PL_ACC(old, -1.f); }
#undef PL_ACC
    }
    const int gw = F.vcu * NWAVES + F.wave, NGW = F.G * NWAVES, lane = F.lane;
    for (int i = gw; i < NDB * 7; i += NGW) { const int bd = i / 7, k = i % 7; const float* src = stp + ((size_t)bd * 15 + 8 + k) * DM; float* dst = a.out + OUT_PSS + ((size_t)bd * 15 + k) * DM;
#pragma unroll
        for (int j = 0; j < 4; ++j) *(f32x4*)(dst + 4 * lane + 256 * j) = *(const f32x4*)(src + 4 * lane + 256 * j);
    }
}

constexpr int NPHASES = 22;
#ifndef PROBE_GEMM_REP
#define PROBE_GEMM_REP 1
#endif
#ifndef PROBE_THIN_REP
#define PROBE_THIN_REP 1
#endif
#ifndef PROBE_THIN_MASK
#define PROBE_THIN_MASK 0
#endif
#define TREPK(k) _Pragma("unroll 1") for (int rep_ = 0; rep_ < (((PROBE_THIN_MASK >> (k)) & 1) ? 2 : 1); ++rep_)
#ifndef MK_PER_PHASE
#define MK_PER_PHASE 0
#endif

#define PROJ1024(Aptr, lda_, Btptr, Ktot, S_, Optr) do { \
        pg8::Gemm gh{(const pg8::bf16_t*)(Aptr), (const pg8::bf16_t*)(Btptr), NR, 1024, (Ktot) / (S_), (lda_), 0, (Ktot)}; pg8::HybridOrder<S_> Sh; Sh.init(NPR, 1024, (Ktot), F.G, (int)blockIdx.x); \
        pg8::EpiHybrid Eh{(pg8::bf16_t*)(Optr), 1024, (float*)(ws + WS_TMPS), (size_t)NSR * 1024}; \
        pg8::gemm_phase<pg8::EpiHybrid, pg8::HybridOrder<S_>, true, true>(F.lds, gh, Sh, Eh); } while (0)

#define AS4 __attribute__((address_space(4)))
__device__ __forceinline__ Args fresh_args() {
    const Args AS4* ap = (const Args AS4*)__builtin_amdgcn_kernarg_segment_ptr();
    asm volatile("" : "+s"(ap));
    Args a;
#pragma unroll
    for (int i = 0; i < 29; ++i) a.in[i] = ap->in[i];
    a.out = ap->out; a.ws = ap->ws; a.ph_lo = ap->ph_lo; a.ph_hi = ap->ph_hi;
    return a;
}
#define PHASE_ARGS const Args args = fresh_args(); unsigned char* const ws = args.ws; float* const out = args.out; float* const MOD = (float*)(ws + WS_MOD); float* const TMP = (float*)(ws + WS_TMP); \
    bf16* const TMPb = (bf16*)(ws + WS_TMP); bf16* const HN = (bf16*)(ws + WS_HN); (void)out; (void)MOD; (void)TMP; (void)TMPb; (void)HN

__device__ __forceinline__ bool fresh(Frame& F) { const int t = opaque_tid(); F.tid = t; F.lane = t & 63; return true; }

__device__ __forceinline__ void ffn_gemms(Frame& F, int L, int pbase, int lo, int hi, const XcdBarrier& bar) {
#define IN(k) ((lo <= (k) && (k) < hi) && fresh(F))
#ifdef PROBE_BAR2
#define SEAM(k) do { if ((lo <= (k) && (k) < hi) && (lo <= (k) + 1 && (k) + 1 < hi)) { xcd_barrier(bar); xcd_barrier(bar); } } while (0)
#else
#define SEAM(k) do { if ((lo <= (k) && (k) < hi) && (lo <= (k) + 1 && (k) + 1 < hi)) xcd_barrier(bar); } while (0)
#endif
    if (IN(pbase)) { PHASE_ARGS;
        pg8::Gemm g{(const pg8::bf16_t*)(ws + WS_HN), (const pg8::bf16_t*)(ws + WS_WUP) + (size_t)L * FF2 * 1024, NR, FF2, 1024, 1024, 0, 1024}; pg8::StaticOrder S; S.init(NR, FF2, F.G, (int)blockIdx.x);
        pg8::EpiBf16<0> E{(pg8::bf16_t*)(ws + WS_U), FF2, nullptr, 0, 0, 1.f};
        pg8::gemm_phase<pg8::EpiBf16<0>, pg8::StaticOrder, true, true>(F.lds, g, S, E);
#ifdef PROBE_UP2
        pg8::gemm_phase<pg8::EpiBf16<0>, pg8::StaticOrder, true, true>(F.lds, g, S, E);
#endif
    }
    SEAM(pbase);
    if (IN(pbase + 1)) { PHASE_ARGS; TREPK(5) ph_conv(F, args, L); }
    SEAM(pbase + 1);
    if (IN(pbase + 2)) { PHASE_ARGS;
        PROJ1024(ws + WS_A2, FF, (const pg8::bf16_t*)(ws + WS_WDOWN) + (size_t)L * 1024 * FF, FF, 11, ws + WS_TMP);
    }
    SEAM(pbase + 2);
#undef IN
#undef SEAM
}

__global__ void __launch_bounds__(NWAVES * 64, 2) fwd(Args args_in_kernarg) {
    extern __shared__ __attribute__((aligned(16))) unsigned char lds[];
    Frame F;
    F.lds = (LAS unsigned char*)lds; F.MISC = (volatile LAS unsigned*)(F.lds + MISC_OFF);
    F.tid = threadIdx.x; F.lane = F.tid & 63; F.wave = __builtin_amdgcn_readfirstlane(F.tid >> 6);
    F.G = gridDim.x; { const int bx = blockIdx.x; F.vcu = (F.G % 8 == 0) ? (bx % 8) * (F.G / 8) + bx / 8 : bx; }
    int lo, hi; { const Args a0 = fresh_args(); F.ctl = (gu32*)(a0.ws + WS_CTL); lo = a0.ph_lo; hi = a0.ph_hi; }
    for (int u = F.tid; u < (LDS_BYTES - LDSCTL_OFF) / 4; u += NWAVES * 64) ((LAS unsigned*)(F.lds + LDSCTL_OFF))[u] = 0u;
    __syncthreads();
    XcdBarrier bar; bar.bar = (unsigned*)(F.ctl + CW_BAR); bar.x = 0; bar.st = nullptr;
    if (hi - lo > 1) bar = xcd_barrier_post((unsigned*)(F.ctl + CW_BAR), F.MISC + 8);
#define IN(k) ((lo <= (k) && (k) < hi) && fresh(F))
#ifdef PROBE_BAR2
#define SEAM(k) do { if ((lo <= (k) && (k) < hi) && (lo <= (k) + 1 && (k) + 1 < hi)) { xcd_barrier(bar); xcd_barrier(bar); } } while (0)
#else
#define SEAM(k) do { if ((lo <= (k) && (k) < hi) && (lo <= (k) + 1 && (k) + 1 < hi)) xcd_barrier(bar); } while (0)
#endif

    const bool defer = F.G >= 96;
    if (IN(0)) { PHASE_ARGS; ph_prologue<0>(F, args, F.vcu * NWAVES + F.wave, F.G * NWAVES); if (!defer) ph_prologue<1>(F, args, F.vcu * NWAVES + F.wave, F.G * NWAVES); }
    SEAM(0);
    if (IN(1)) { PHASE_ARGS;
        pg8::Gemm g{(const pg8::bf16_t*)(ws + WS_SILUC), (const pg8::bf16_t*)(ws + WS_ADAT), 256, 12288, 1024, 1024, 0, 1024}; pg8::StaticOrder S; S.init(256, 12288, F.G, (int)blockIdx.x);
        pg8::EpiF32 E{MOD, 12288, (const float*)args.in[10], nullptr, 0};
        pg8::gemm_phase<pg8::EpiF32, pg8::StaticOrder, true, true>(F.lds, g, S, E);
        if (defer && (int)blockIdx.x >= 48) ph_prologue<1>(F, args, ((int)blockIdx.x - 48) * NWAVES + F.wave, (F.G - 48) * NWAVES);
    }
    SEAM(1);
    if (IN(2)) { PHASE_ARGS; TREPK(1) ph_rowop<false, 1>(F, (const float*)args.in[0], (const float*)args.in[1], nullptr, nullptr, MOD, nullptr, 0, nullptr, 0 * 1024, 1 * 1024, (const float*)args.in[11], HN, nullptr); }
    SEAM(2);
    if (IN(3)) { PHASE_ARGS;
        PROJ1024(HN, 1024, ws + WS_WDQKV, 1024, 4, TMPb);
    }
    SEAM(3);
    if (IN(4)) { PHASE_ARGS; TREPK(2) ph_qkvpost(F, args); }
    SEAM(4);
    if (IN(5)) { PHASE_ARGS;
        pg8::Gemm g{(const pg8::bf16_t*)(ws + WS_CQ), (const pg8::bf16_t*)(ws + WS_WUQ), NR, 1536, QL, QL, 0, QL}; pg8::StaticOrder S; S.init(NR, 1536, F.G, (int)blockIdx.x);
        pg8::EpiQRope E{(pg8::bf16_t*)(ws + WS_QP), (const float*)(ws + WS_COS), (const float*)(ws + WS_SIN), (pg8::bf16_t*)(ws + WS_QD)};
        pg8::gemm_phase<pg8::EpiQRope, pg8::StaticOrder, true, true>(F.lds, g, S, E);
        pg8::Gemm g2{(const pg8::bf16_t*)(ws + WS_CQ) + (size_t)NPR * QL, (const pg8::bf16_t*)(ws + WS_WABS), NSR, 4096, QL, QL, 0, QL}; pg8::StaticOrder S2; S2.init(NSR, 4096, F.G, F.G - 1 - (int)blockIdx.x);
        pg8::EpiQD E2{(pg8::bf16_t*)(ws + WS_QD)};
        pg8::gemm_phase<pg8::EpiQD, pg8::StaticOrder, true, true>(F.lds, g2, S2, E2);
    }
    if (IN(6)) { PHASE_ARGS;
        pg8::Gemm g{(const pg8::bf16_t*)(ws + WS_CKV), (const pg8::bf16_t*)(ws + WS_WKVUP), NPR, 2048, KVL, KVL, 0, KVL}; pg8::StaticOrder S; S.init(NPR, 2048, F.G, (int)blockIdx.x);
        pg8::EpiBf16<0> E{(pg8::bf16_t*)(ws + WS_KN), 1024, nullptr, 1024, (size_t)(WS_VV - WS_KN) / 2, 1.f};
        pg8::gemm_phase<pg8::EpiBf16<0>, pg8::StaticOrder, true, true>(F.lds, g, S, E);
    }
    SEAM(6);
    if (IN(7)) { PHASE_ARGS; ph_attention(F, args); }
    SEAM(7);
    if (IN(8)) { PHASE_ARGS; TREPK(4) ph_dcombine(F, args); }
    SEAM(8);
    if (IN(9)) { PHASE_ARGS;
        PROJ1024(ws + WS_O, 1024, ws + WS_WO, 1024, 4, TMPb);
    }
    SEAM(9);
    if (IN(10)) { PHASE_ARGS; TREPK(1) ph_rowop<true, 1>(F, (const float*)args.in[0], (const float*)args.in[1], out, TMPb, MOD, nullptr, 2 * 1024, (const float*)args.in[12], 3 * 1024, 4 * 1024, (const float*)args.in[13], HN, nullptr, (const float*)(ws + WS_TMPS), 4, nullptr, (bf16*)(ws + WS_XB)); }
    SEAM(10);
    ffn_gemms(F, 0, 11, lo, hi, bar);
    if (IN(14)) { PHASE_ARGS; ph_rowop<true, 2>(F, out, out + (size_t)NPR * DM, out, TMPb, MOD, nullptr, 5 * 1024, (const float*)args.in[14], 6144 + 0 * 1024, 6144 + 1 * 1024, (const float*)args.in[11] + DM, (bf16*)(ws + WS_H1), out, (const float*)(ws + WS_TMPS), 11, (const bf16*)(ws + WS_XB), (bf16*)(ws + WS_XB)); }
    SEAM(14);
    if (IN(15)) { PHASE_ARGS; TREPK(6) ph_pool(F, args); }
    SEAM(15);
    if (IN(16)) { PHASE_ARGS;
        pg8::Gemm g{(const pg8::bf16_t*)(ws + WS_POOLED), (const pg8::bf16_t*)(ws + WS_POOLT), NR, 1024, 256, 1024, 256, 256}; pg8::StaticOrder S; S.init(NR, 1024, F.G, (int)blockIdx.x);
        pg8::EpiBf16<0> E{(pg8::bf16_t*)TMPb, 1024, nullptr, 0, 0, 1.f};
        pg8::gemm_phase<pg8::EpiBf16<0>, pg8::StaticOrder, true, true>(F.lds, g, S, E);
    }
    SEAM(16);
    if (IN(17)) { PHASE_ARGS; ph_rowop<true, 1>(F, out, out + (size_t)NPR * DM, out, TMPb, MOD, (const float*)args.in[24], 6144 + 2 * 1024, (const float*)args.in[12] + DM, 6144 + 3 * 1024, 6144 + 4 * 1024, (const float*)args.in[13] + DM, HN, nullptr, nullptr, 0, (const bf16*)(ws + WS_XB), (bf16*)(ws + WS_XB)); }
    SEAM(17);
    ffn_gemms(F, 1, 18, lo, hi, bar);
    if (IN(21)) { PHASE_ARGS; ph_rowop<true, 0>(F, out, out + (size_t)NPR * DM, out, TMPb, MOD, nullptr, 6144 + 5 * 1024, (const float*)args.in[14] + DM, 0, 0, nullptr, nullptr, nullptr, (const float*)(ws + WS_TMPS), 11, (const bf16*)(ws + WS_XB), nullptr); }
#undef IN
#undef SEAM
}

extern "C" void kernel_launch(void* const* d_in, const int* in_sizes, int n_in, void* d_out, int out_size, void* d_ws, size_t ws_size, hipStream_t stream) {
    static int grid = 0;
    if (grid == 0) {
        if (n_in != 29 || (size_t)out_size != OUT_TOTAL || ws_size < WS_END) { fprintf(stderr, "kernel_launch: unexpected shapes (n_in %d, out %d, ws %zu); nothing launched\n", n_in, out_size, ws_size); grid = -1; return; }
        int dev = 0, cus = 0, per_cu = 0;
        if (hipGetDevice(&dev) != hipSuccess || hipDeviceGetAttribute(&cus, hipDeviceAttributeMultiprocessorCount, dev) != hipSuccess) { grid = -1; return; }
        if (hipFuncSetAttribute((const void*)fwd, hipFuncAttributeMaxDynamicSharedMemorySize, LDS_BYTES) != hipSuccess) { fprintf(stderr, "kernel_launch: hipFuncSetAttribute failed\n"); grid = -1; return; }
        if (hipOccupancyMaxActiveBlocksPerMultiprocessor(&per_cu, (const void*)fwd, NWAVES * 64, LDS_BYTES) != hipSuccess || per_cu < 1) { fprintf(stderr, "kernel_launch: occupancy query reports %d workgroups per CU\n", per_cu); }
        (void)hipGetLastError();
        if (cus < 176) { fprintf(stderr, "kernel_launch: needs >= 176 CUs\n"); grid = -1; return; }
        grid = cus;
    }
    if (grid < 0) return;
    if (hipMemsetAsync((char*)d_ws + WS_CTL, 0, CTL_ZERO_BYTES, stream) != hipSuccess) return;
    Args a{};
    for (int i = 0; i < 29; ++i) a.in[i] = d_in[i];
    a.out = (float*)d_out; a.ws = (unsigned char*)d_ws;
#if MK_PER_PHASE
    for (int k = 0; k < NPHASES; ++k) { a.ph_lo = k; a.ph_hi = k + 1; hipLaunchKernelGGL(fwd, dim3(grid), dim3(NWAVES * 64), LDS_BYTES, stream, a);
#ifdef PROBE_PHASE_TWICE
        if (k == PROBE_PHASE_TWICE) hipLaunchKernelGGL(fwd, dim3(grid), dim3(NWAVES * 64), LDS_BYTES, stream, a);
#endif
    }
#else
    a.ph_lo = 0; a.ph_hi = NPHASES; hipLaunchKernelGGL(fwd, dim3(grid), dim3(NWAVES * 64), LDS_BYTES, stream, a);
#endif
}
```
